# Optimizing an MI355X kernel written in HIP

```python
import math
import jax, jax.numpy as jnp
from jax import lax
import numpy as np

D_MODEL = 1024
BATCH = 8
SEQ = 2048
DEPTH = 1

CHUNK = 64
LEFT_CHUNKS = 8
BAND = (LEFT_CHUNKS + 1) * CHUNK
Q_BLOCK = 128
EPS = 1e-6
NEG = -1e30

A_HEADS = 8
A_HEAD_DIM = 64
A_WIDTH = A_HEADS * A_HEAD_DIM
REL_CLIP = 128

B_HEADS = 4
B_HEAD_DIM = 64
B_V_DIM = 2 * B_HEAD_DIM
B_QK_WIDTH = B_HEADS * 2 * B_HEAD_DIM
B_WIDTH = B_HEADS * B_V_DIM
T5_BUCKETS = 32
T5_MAX_DIST = 128

N_BRANCH = 2
D_FF = 2816
MIX_IN = 3 * A_WIDTH + 2 * B_QK_WIDTH + B_WIDTH + N_BRANCH * D_MODEL
SPLITS = list(np.cumsum([A_WIDTH, A_WIDTH, A_WIDTH, B_QK_WIDTH, B_QK_WIDTH, B_WIDTH]).tolist())

kernel_name = "hybrid_chunk_band_diff_attn_gated_macaron"


def rms_norm(x, g):
    xf = x.astype(jnp.float32)
    y = xf * lax.rsqrt(jnp.mean(xf * xf, axis=-1, keepdims=True) + EPS)
    return (y * g.astype(jnp.float32)).astype(x.dtype)


def swiglu_ffn(x, w_in, w_out):
    gate, up = jnp.split(x @ w_in, 2, axis=-1)
    return (jax.nn.silu(gate) * up) @ w_out


def t5_bucket(rel):
    nb = T5_BUCKETS // 2
    ret = jnp.where(rel > 0, nb, 0)
    n = jnp.abs(rel)
    max_exact = nb // 2
    nf = jnp.maximum(n, 1).astype(jnp.float32)
    large = max_exact + (jnp.log(nf / max_exact) / math.log(T5_MAX_DIST / max_exact)
                         * (nb - max_exact)).astype(jnp.int32)
    large = jnp.minimum(large, nb - 1)
    return ret + jnp.where(n < max_exact, n, large)


def chunked_band_attention(q, k, v, rel_table):
    b, s, h, d = q.shape
    nc = s // CHUNK
    qc = q.reshape(b, nc, CHUNK, h, d)
    pad = ((0, 0), (LEFT_CHUNKS * CHUNK, 0), (0, 0), (0, 0))
    kp = jnp.pad(k, pad).reshape(b, nc + LEFT_CHUNKS, CHUNK, h, d)
    vp = jnp.pad(v, pad).reshape(b, nc + LEFT_CHUNKS, CHUNK, h, d)
    kb = jnp.concatenate([kp[:, i:i + nc] for i in range(LEFT_CHUNKS + 1)], axis=2)
    vb = jnp.concatenate([vp[:, i:i + nc] for i in range(LEFT_CHUNKS + 1)], axis=2)
    sc = jnp.einsum('bcqhd,bckhd->bhcqk', qc, kb).astype(jnp.float32) * (d ** -0.5)
    qi = jnp.arange(CHUNK)[:, None]
    kj = jnp.arange(BAND)[None, :]
    rel = kj - LEFT_CHUNKS * CHUNK - qi
    bias = rel_table[:, jnp.clip(rel, -REL_CLIP, REL_CLIP) + REL_CLIP]
    sc = sc + bias[:, None].astype(jnp.float32)
    key_pos = (jnp.arange(nc)[:, None] - LEFT_CHUNKS) * CHUNK + jnp.arange(BAND)[None, :]
    sc = jnp.where((key_pos >= 0)[None, None, :, None, :], sc, NEG)
    p = jax.nn.softmax(sc, axis=-1).astype(v.dtype)
    o = jnp.einsum('bhcqk,bckhd->bcqhd', p, vb)
    return o.reshape(b, s, h * d)


def diff_attention(q, k, v, t5_table, lam, lambda_init, subln_g):
    b, s, h, _, d = q.shape
    nqb = s // Q_BLOCK
    qblocks = q.reshape(b, nqb, Q_BLOCK, h, 2, d).transpose(1, 0, 2, 3, 4, 5)
    key_pos = jnp.arange(s)
    key_chunk = key_pos // CHUNK
    scale = d ** -0.5

    def block(args):
        qblk, bi = args
        q_pos = bi * Q_BLOCK + jnp.arange(Q_BLOCK)
        sc = jnp.einsum('bqhrd,bkhrd->bhrqk', qblk, k).astype(jnp.float32) * scale
        bias = t5_table[:, t5_bucket(key_pos[None, :] - q_pos[:, None])]
        sc = sc + bias[None, :, None].astype(jnp.float32)
        allowed = key_chunk[None, :] <= (q_pos // CHUNK)[:, None]
        sc = jnp.where(allowed, sc, NEG)
        p = jax.nn.softmax(sc, axis=-1)
        attn = p[:, :, 0] - lam * p[:, :, 1]
        return jnp.einsum('bhqk,bkhe->bqhe', attn.astype(v.dtype), v)

    o = lax.map(block, (qblocks, jnp.arange(nqb)))
    o = o.transpose(1, 0, 2, 3, 4).reshape(b, s, h, 2 * d)
    o = rms_norm(o, subln_g) * (1.0 - lambda_init)
    return o.reshape(b, s, h * 2 * d)


def setup_inputs(seed: int = 0) -> dict:
    key = jax.random.key(seed)
    ks = jax.random.split(key, 24)

    def dense(k, shape, fan_in):
        return jax.random.normal(k, shape, jnp.float32) * (fan_in ** -0.5)

    def gain(k, shape):
        return 1.0 + 0.05 * jax.random.normal(k, shape, jnp.float32)

    L = DEPTH
    return {
        "x": jax.random.normal(ks[0], (BATCH, SEQ, D_MODEL), jnp.float32),
        "ffn1_norm": gain(ks[1], (L, D_MODEL)),
        "ffn1_w_in": dense(ks[2], (L, D_MODEL, 2 * D_FF), D_MODEL),
        "ffn1_w_out": dense(ks[3], (L, D_FF, D_MODEL), D_FF),
        "mix_norm": gain(ks[4], (L, D_MODEL)),
        "w_mix_in": dense(ks[5], (L, D_MODEL, MIX_IN), D_MODEL),
        "b_gate": 0.02 * jax.random.normal(ks[6], (L, N_BRANCH * D_MODEL), jnp.float32),
        "rel_bias_a": 0.1 * jax.random.normal(ks[7], (L, A_HEADS, 2 * REL_CLIP + 1), jnp.float32),
        "lambda_q1": 0.1 * jax.random.normal(ks[8], (L, B_HEAD_DIM), jnp.float32),
        "lambda_k1": 0.1 * jax.random.normal(ks[9], (L, B_HEAD_DIM), jnp.float32),
        "lambda_q2": 0.1 * jax.random.normal(ks[10], (L, B_HEAD_DIM), jnp.float32),
        "lambda_k2": 0.1 * jax.random.normal(ks[11], (L, B_HEAD_DIM), jnp.float32),
        "subln_g": gain(ks[12], (L, B_V_DIM)),
        "t5_bias": 0.1 * jax.random.normal(ks[13], (B_HEADS, T5_BUCKETS), jnp.float32),
        "w_branch_a": dense(ks[14], (L, A_WIDTH, D_MODEL), A_WIDTH),
        "w_branch_b": dense(ks[15], (L, B_WIDTH, D_MODEL), B_WIDTH),
        "w_o": dense(ks[16], (L, D_MODEL, D_MODEL), D_MODEL),
        "ffn2_norm": gain(ks[17], (L, D_MODEL)),
        "ffn2_w_in": dense(ks[18], (L, D_MODEL, 2 * D_FF), D_MODEL),
        "ffn2_w_out": dense(ks[19], (L, D_FF, D_MODEL), D_FF),
        "final_norm": gain(ks[20], (D_MODEL,)),
    }


def reference(x, ffn1_norm, ffn1_w_in, ffn1_w_out, mix_norm, w_mix_in, b_gate, rel_bias_a,
              lambda_q1, lambda_k1, lambda_q2, lambda_k2, subln_g, t5_bias,
              w_branch_a, w_branch_b, w_o, ffn2_norm, ffn2_w_in, ffn2_w_out, final_norm):
    b, s, _ = x.shape
    for li in range(DEPTH):
        x = x + 0.5 * swiglu_ffn(rms_norm(x, ffn1_norm[li]), ffn1_w_in[li], ffn1_w_out[li])

        u = rms_norm(x, mix_norm[li])
        proj = u @ w_mix_in[li]
        q_a, k_a, v_a, q_b, k_b, v_b, gate_logits = jnp.split(proj, SPLITS, axis=-1)

        y_a = chunked_band_attention(q_a.reshape(b, s, A_HEADS, A_HEAD_DIM),
                                     k_a.reshape(b, s, A_HEADS, A_HEAD_DIM),
                                     v_a.reshape(b, s, A_HEADS, A_HEAD_DIM),
                                     rel_bias_a[li])

        lambda_init = 0.8 - 0.6 * math.exp(-0.3 * li)
        lam = (jnp.exp(jnp.sum(lambda_q1[li].astype(jnp.float32) * lambda_k1[li].astype(jnp.float32)))
               - jnp.exp(jnp.sum(lambda_q2[li].astype(jnp.float32) * lambda_k2[li].astype(jnp.float32)))
               + lambda_init)
        y_b = diff_attention(q_b.reshape(b, s, B_HEADS, 2, B_HEAD_DIM),
                             k_b.reshape(b, s, B_HEADS, 2, B_HEAD_DIM),
                             v_b.reshape(b, s, B_HEADS, B_V_DIM),
                             t5_bias, lam, lambda_init, subln_g[li])

        g_a, g_b = jnp.split(jax.nn.sigmoid(gate_logits + b_gate[li]), 2, axis=-1)
        merged = g_a * (y_a @ w_branch_a[li]) + g_b * (y_b @ w_branch_b[li])
        x = x + merged @ w_o[li]

        x = x + 0.5 * swiglu_ffn(rms_norm(x, ffn2_norm[li]), ffn2_w_in[li], ffn2_w_out[li])
    return rms_norm(x, final_norm)
```

```cpp
#include <hip/hip_runtime.h>
#include <hip/hip_cooperative_groups.h>
#include <cstdio>
#include <cstdint>
namespace cg = cooperative_groups;

#ifndef MK_N_LAUNCHES
#define MK_N_LAUNCHES 10
#endif

#define LAS __attribute__((address_space(3)))
#define GAS __attribute__((address_space(1)))
typedef unsigned short bf16_t;
typedef short bf16x8 __attribute__((ext_vector_type(8)));
typedef short s16x4 __attribute__((ext_vector_type(4)));
typedef float f32x4 __attribute__((ext_vector_type(4)));
typedef float f32x16 __attribute__((ext_vector_type(16)));
typedef float f32x2 __attribute__((ext_vector_type(2)));
typedef unsigned u32x4 __attribute__((ext_vector_type(4)));
typedef unsigned u32x2 __attribute__((ext_vector_type(2)));
typedef __bf16 bf16x2_t __attribute__((ext_vector_type(2)));

constexpr int BATCH = 8, SEQ = 2048, DM = 1024, M = BATCH * SEQ;
constexpr int DFF = 2816, NFF = 2 * DFF, NMIX = 5120;
constexpr float EPS = 1e-6f;
constexpr float LOG2E = 1.4426950408889634f;
constexpr float QSCALE = 0.125f * LOG2E;
constexpr int NWAVES = 8;

constexpr size_t MiB = 1u << 20;
constexpr size_t WS_CTL = 0, CTL_ZERO_BYTES = 64 * 1024;
constexpr size_t WS_SSQ0 = 1 * MiB, WS_SSQ1 = 2 * MiB, WS_SSQ2 = 3 * MiB, WS_SSQ3 = 4 * MiB;
constexpr size_t WS_WIN1 = 5 * MiB, WS_WOUT1 = 16 * MiB, WS_WMIX = 22 * MiB, WS_WA = 32 * MiB, WS_WB = 33 * MiB, WS_WO = 34 * MiB, WS_WIN2 = 36 * MiB, WS_WOUT2 = 47 * MiB;
constexpr size_t WS_XB = 53 * MiB;
constexpr size_t WS_R = 85 * MiB;
constexpr size_t WS_H = WS_R;
constexpr size_t WS_QQ = WS_R, WS_KA = WS_R + 32 * MiB, WS_VA = WS_R + 48 * MiB, WS_KB = WS_R + 64 * MiB, WS_VB = WS_R + 80 * MiB, WS_GA = WS_R + 96 * MiB, WS_GB = WS_R + 128 * MiB;
constexpr size_t WS_MG = WS_KA;
constexpr size_t WS_END = WS_R + 160 * MiB;
static_assert(WS_END <= 256 * MiB, "d_ws map");
static_assert(WS_WOUT2 + (size_t)DM * DFF * 2 <= WS_XB && WS_XB + (size_t)M * DM * 2 <= WS_R && WS_H + (size_t)M * DFF * 2 <= WS_END, "d_ws map");
constexpr int CW_BAR = 1024;

constexpr int RING_BYTES = 131072;
constexpr int LDSCTL_OFF = RING_BYTES, MISC_OFF = LDSCTL_OFF + 320;
constexpr int LDS_BYTES = 147456;

__device__ __forceinline__ unsigned cvt_pk_bf16(float lo, float hi) { f32x2 v = {lo, hi}; bf16x2_t b = __builtin_convertvector(v, bf16x2_t); return __builtin_bit_cast(unsigned, b); }
__device__ __forceinline__ float bf16lo(unsigned w) { return __uint_as_float(w << 16); }
__device__ __forceinline__ float bf16hi(unsigned w) { return __uint_as_float(w & 0xffff0000u); }
__device__ __forceinline__ float fast_rcp(float x) { return __builtin_amdgcn_rcpf(x); }
__device__ __forceinline__ float fast_exp2(float x) { return __builtin_amdgcn_exp2f(x); }
__device__ __forceinline__ float sigmoidf_(float v) { return fast_rcp(1.0f + fast_exp2(-v * LOG2E)); }
__device__ __forceinline__ float wave_sum(float v) {
#pragma unroll
    for (int o = 1; o < 64; o <<= 1) v += __shfl_xor(v, o);
    return v;
}
__device__ __forceinline__ float row_rstd(const float* ssq, int row) {
    const f32x4* p = (const f32x4*)(ssq + (size_t)row * 16);
    const f32x4 a = p[0], b = p[1], c = p[2], d = p[3];
    const float s = (((a.x + a.y) + (a.z + a.w)) + ((b.x + b.y) + (b.z + b.w))) + (((c.x + c.y) + (c.z + c.w)) + ((d.x + d.y) + (d.z + d.w)));
    return __builtin_amdgcn_rsqf(s * (1.0f / DM) + EPS);
}

namespace pg8 {
constexpr int BM = 256, BK = 64, HALF = 128, HTB = HALF * BK * 2, STAGE_BYTES = 8 * HTB, NXCD = 8, WGM = 8;
__host__ __device__ __forceinline__ int lds_byte(int r, int c) { const int st = (r >> 4) * 2 + (c >> 5), rr = r & 15, cc = c & 31, ob = rr * 64 + cc * 2; return st * 1024 + (ob ^ (((ob >> 9) & 1) << 5)); }
__host__ __device__ __forceinline__ void stage_rc(int b, int& R, int& C) { const int st = b / 1024, sb = b % 1024, swz = sb ^ (((sb >> 9) & 1) << 5); R = (st >> 1) * 16 + swz / 64; C = (st & 1) * 32 + (swz % 64) / 2; }
__host__ __device__ __forceinline__ int perm32(int rho) { const int n = rho >> 4, i = rho & 15; return 8 * (i >> 2) + 4 * n + (i & 3); }

struct Unit { int pm, pn, aux; };
struct Gemm { int lda, ldb, K; };

__device__ __forceinline__ void tile_of(int L, int nM, int nN, int& pm, int& pn) {
    const int nwg = nM * nN; int wgid = L;
    { const int q = nwg / NXCD, r = nwg % NXCD, xcd = wgid % NXCD, off = wgid / NXCD; wgid = (xcd < r ? xcd * (q + 1) : r * (q + 1) + (xcd - r) * q) + off; }
    const int nig = WGM * nN, gid = wgid / nig, fm = gid * WGM, gsz = (nM - fm) < WGM ? (nM - fm) : WGM;
    pm = fm + ((wgid % nig) % gsz); pn = (wgid % nig) / gsz;
}
struct StaticOrder {
    const bf16_t* A; const bf16_t* Bt; int lda, ldb, nM, nN, G, c;
    __device__ __forceinline__ bool next(int i, Unit& u) const { const long L = (long)i * G + c; if (L >= (long)nM * nN) return false; tile_of((int)L, nM, nN, u.pm, u.pn); u.aux = 0; return true; }
    __device__ __forceinline__ const char* aptr(const Unit& u) const { return (const char*)(A + (size_t)u.pm * BM * lda); }
    __device__ __forceinline__ const char* bptr(const Unit& u) const { return (const char*)(Bt + (size_t)u.pn * BM * ldb); }
};
struct BranchOrder {
    const bf16_t *A0, *A1, *B0, *B1; int lda, ldb, nM, nN, G, c;
    __device__ __forceinline__ bool next(int i, Unit& u) const { const long L = (long)(i >> 1) * G + c; if (L >= (long)nM * nN) return false; tile_of((int)L, nM, nN, u.pm, u.pn); u.aux = i & 1; return true; }
    __device__ __forceinline__ const char* aptr(const Unit& u) const { return (const char*)((u.aux ? A1 : A0) + (size_t)u.pm * BM * lda); }
    __device__ __forceinline__ const char* bptr(const Unit& u) const { return (const char*)((u.aux ? B1 : B0) + (size_t)u.pn * BM * ldb); }
};

typedef f32x4 Acc[2][2][4][2];

struct EpiSwiglu {
    static constexpr bool PERM = true;
    bf16_t* H; const float* ssq;
    __device__ __forceinline__ bool keep(const Unit&) const { return false; }
    __device__ __forceinline__ void operator()(Acc& acc, const Unit& u, int wr, int wc, int fr, int fq) const {
#pragma unroll
        for (int ai = 0; ai < 2; ++ai)
#pragma unroll
            for (int m = 0; m < 4; ++m) {
                const int row = u.pm * BM + ai * HALF + wr * 64 + m * 16 + fr; const float rs = row_rstd(ssq, row);
                float h[8];
#pragma unroll
                for (int n = 0; n < 2; ++n)
#pragma unroll
                    for (int e = 0; e < 4; ++e) { const float g = acc[ai][0][m][n][e] * rs, up = acc[ai][1][m][n][e] * rs; h[n * 4 + e] = g * sigmoidf_(g) * up; }
                u32x4 w; w.x = cvt_pk_bf16(h[0], h[1]); w.y = cvt_pk_bf16(h[2], h[3]); w.z = cvt_pk_bf16(h[4], h[5]); w.w = cvt_pk_bf16(h[6], h[7]);
                *(u32x4*)(H + (size_t)row * DFF + u.pn * HALF + wc * 32 + 8 * fq) = w;
            }
    }
};
struct EpiResid {
    static constexpr bool PERM = false;
    const float* base; float* out; bf16_t* xb; float* ssq; float alpha;
    __device__ __forceinline__ bool keep(const Unit&) const { return false; }
    __device__ __forceinline__ void operator()(Acc& acc, const Unit& u, int wr, int wc, int fr, int fq) const {
        const int col0 = u.pn * BM + wc * 32 + 4 * fq;
#pragma unroll
        for (int ai = 0; ai < 2; ++ai)
#pragma unroll
            for (int m = 0; m < 4; ++m) {
                const int row = u.pm * BM + ai * HALF + wr * 64 + m * 16 + fr; const size_t off = (size_t)row * DM + col0; float s = 0.f;
#pragma unroll
                for (int bj = 0; bj < 2; ++bj)
#pragma unroll
                    for (int n = 0; n < 2; ++n) {
                        const f32x4 bs = *(const f32x4*)(base + off + bj * HALF + n * 16); const f32x4 v = bs + acc[ai][bj][m][n] * alpha;
                        *(f32x4*)(out + off + bj * HALF + n * 16) = v; s += (v.x * v.x + v.y * v.y) + (v.z * v.z + v.w * v.w);
                        if (xb) { u32x2 w; w.x = cvt_pk_bf16(v.x, v.y); w.y = cvt_pk_bf16(v.z, v.w); *(u32x2*)(xb + off + bj * HALF + n * 16) = w; }
                    }
                s += __shfl_xor(s, 16); s += __shfl_xor(s, 32);
                if (fq == 0) ssq[(size_t)row * 16 + u.pn * 4 + wc] = s;
            }
    }
};
struct EpiMix {
    static constexpr bool PERM = true;
    bf16_t *QQ, *KA, *VA, *KB, *VB, *GA, *GB; const float* ssq; const float* bgate;
    __device__ __forceinline__ bool keep(const Unit&) const { return false; }
    __device__ __forceinline__ void operator()(Acc& acc, const Unit& u, int wr, int wc, int fr, int fq) const {
        const int pn = u.pn; bf16_t* dst; int ld; float sc = 1.f; bool gate = false; int gcol = 0;
        if (pn < 2) { dst = QQ + pn * 256; ld = 1024; sc = QSCALE; }
        else if (pn < 4) { dst = KA + (pn - 2) * 256; ld = 512; }
        else if (pn < 6) { dst = VA + (pn - 4) * 256; ld = 512; }
        else if (pn < 8) { dst = QQ + 512 + (pn - 6) * 256; ld = 1024; sc = QSCALE; }
        else if (pn < 10) { dst = KB + (pn - 8) * 256; ld = 512; }
        else if (pn < 12) { dst = VB + (pn - 10) * 256; ld = 512; }
        else if (pn < 16) { dst = GA + (pn - 12) * 256; ld = 1024; gate = true; gcol = (pn - 12) * 256; }
        else { dst = GB + (pn - 16) * 256; ld = 1024; gate = true; gcol = (pn - 12) * 256; }
        const int cw = wc * 32 + 8 * fq;
        f32x4 bv[2][2];
#pragma unroll
        for (int bj = 0; bj < 2; ++bj)
#pragma unroll
            for (int n = 0; n < 2; ++n) bv[bj][n] = gate ? *(const f32x4*)(bgate + gcol + bj * HALF + cw + 4 * n) : (f32x4){0.f, 0.f, 0.f, 0.f};
#pragma unroll
        for (int ai = 0; ai < 2; ++ai)
#pragma unroll
            for (int m = 0; m < 4; ++m) {
                const int row = u.pm * BM + ai * HALF + wr * 64 + m * 16 + fr; const float rs = row_rstd(ssq, row) * sc;
                bf16_t* rowp = dst + (size_t)row * ld + cw;
#pragma unroll
                for (int bj = 0; bj < 2; ++bj) {
                    f32x4 v0 = acc[ai][bj][m][0] * rs, v1 = acc[ai][bj][m][1] * rs;
                    if (gate) {
                        v0 = v0 + bv[bj][0]; v1 = v1 + bv[bj][1];
                        v0 = (f32x4){sigmoidf_(v0.x), sigmoidf_(v0.y), sigmoidf_(v0.z), sigmoidf_(v0.w)}; v1 = (f32x4){sigmoidf_(v1.x), sigmoidf_(v1.y), sigmoidf_(v1.z), sigmoidf_(v1.w)};
                    }
                    u32x4 w; w.x = cvt_pk_bf16(v0.x, v0.y); w.y = cvt_pk_bf16(v0.z, v0.w); w.z = cvt_pk_bf16(v1.x, v1.y); w.w = cvt_pk_bf16(v1.z, v1.w);
                    *(u32x4*)(rowp + bj * HALF) = w;
                }
            }
    }
};
struct EpiBranch {
    static constexpr bool PERM = true;
    const bf16_t *GA, *GB; bf16_t* MG;
    __device__ __forceinline__ bool keep(const Unit& u) const { return u.aux == 0; }
    __device__ __forceinline__ void operator()(Acc& acc, const Unit& u, int wr, int wc, int fr, int fq) const {
        const int col0 = u.pn * BM + wc * 32 + 8 * fq;
#pragma unroll
        for (int ai = 0; ai < 2; ++ai)
#pragma unroll
            for (int m = 0; m < 4; ++m) {
                const int row = u.pm * BM + ai * HALF + wr * 64 + m * 16 + fr; const size_t off = (size_t)row * DM + col0;
#pragma unroll
                for (int bj = 0; bj < 2; ++bj) {
                    const u32x4 gb = *(const u32x4*)(GB + off + bj * HALF);
                    float b[8] = {bf16lo(gb.x), bf16hi(gb.x), bf16lo(gb.y), bf16hi(gb.y), bf16lo(gb.z), bf16hi(gb.z), bf16lo(gb.w), bf16hi(gb.w)};
#pragma unroll
                    for (int e = 0; e < 8; ++e) b[e] = fmaxf(b[e], 1e-30f);
                    if (u.aux == 0) {
                        const u32x4 ga = *(const u32x4*)(GA + off + bj * HALF);
                        const float a[8] = {bf16lo(ga.x), bf16hi(ga.x), bf16lo(ga.y), bf16hi(ga.y), bf16lo(ga.z), bf16hi(ga.z), bf16lo(ga.w), bf16hi(ga.w)};
#pragma unroll
                        for (int e = 0; e < 8; ++e) acc[ai][bj][m][e >> 2][e & 3] *= a[e] / b[e];
                    } else {
                        float v[8];
#pragma unroll
                        for (int e = 0; e < 8; ++e) v[e] = acc[ai][bj][m][e >> 2][e & 3] * b[e];
                        u32x4 w; w.x = cvt_pk_bf16(v[0], v[1]); w.y = cvt_pk_bf16(v[2], v[3]); w.z = cvt_pk_bf16(v[4], v[5]); w.w = cvt_pk_bf16(v[6], v[7]);
                        *(u32x4*)(MG + off + bj * HALF) = w;
                    }
                }
            }
    }
};

template <class Epi, class Sched>
__device__ __forceinline__ void gemm_phase(LAS unsigned char* lds, const Gemm g, const Sched& S, const Epi& E) {
    const int tid = threadIdx.x, wid = __builtin_amdgcn_readfirstlane(tid >> 6), lane = tid & 63, wr = wid >> 2, wc = wid & 3, fr = lane & 15, fq = lane >> 4;
    const int K = g.K, nt = K / BK;
    unsigned voffA[2], voffB[2];
#pragma unroll
    for (int i = 0; i < 2; ++i) { int R, C; stage_rc(tid * 16 + i * 8192, R, C); const int Rb = Epi::PERM ? ((R & ~31) + perm32(R & 31)) : R;
        voffA[i] = (unsigned)(R * g.lda + C) * 2u; voffB[i] = (unsigned)(Rb * g.ldb + C) * 2u; }
    const size_t kstep = (size_t)(BK * 2);
    const size_t hstepA = (size_t)HALF * g.lda * 2, hstepB = (size_t)HALF * g.ldb * 2;
    const unsigned ldsw = (unsigned)wid * 1024u;
    const int aoff = lds_byte(wr * 64 + fr, fq * 8), boff = lds_byte(wc * 32 + fr, fq * 8);
#define PG8_SA(b, h) (((b) * 2 + (h)) * HTB)
#define PG8_SB(b, h) ((4 + (b) * 2 + (h)) * HTB)
#define PG8_STAGE(bufoff, gbase, voff) do { _Pragma("unroll") for (int _i = 0; _i < 2; ++_i) \
        __builtin_amdgcn_global_load_lds((const unsigned*)((const char*)(gbase) + (voff)[_i]), (LAS unsigned*)(lds + (bufoff) + ldsw + _i * 8192), 16, 0, 0); } while (0)
#define PG8_LDA(dst, b, h) do { _Pragma("unroll") for (int m = 0; m < 4; ++m) _Pragma("unroll") for (int k = 0; k < 2; ++k) dst[m][k] = *(const LAS bf16x8*)(lds + PG8_SA(b, h) + aoff + m * 2048 + k * 1024); } while (0)
#define PG8_LDB(dst, b, h) do { _Pragma("unroll") for (int n = 0; n < 2; ++n) _Pragma("unroll") for (int k = 0; k < 2; ++k) dst[n][k] = *(const LAS bf16x8*)(lds + PG8_SB(b, h) + boff + n * 2048 + k * 1024); } while (0)
#define PG8_MMA(ai, bj, At, Bt) do { __builtin_amdgcn_s_setprio(1); _Pragma("unroll") for (int m = 0; m < 4; ++m) _Pragma("unroll") for (int n = 0; n < 2; ++n) _Pragma("unroll") for (int k = 0; k < 2; ++k) \
        acc[ai][bj][m][n] = __builtin_amdgcn_mfma_f32_16x16x32_bf16(Bt[n][k], At[m][k], acc[ai][bj][m][n], 0, 0, 0); __builtin_amdgcn_s_setprio(0); } while (0)
#define PG8_WAIT_V(n) asm volatile("s_waitcnt vmcnt(" #n ")" ::: "memory")
#define PG8_WAIT_L(n) asm volatile("s_waitcnt lgkmcnt(" #n ")" ::: "memory")
#define PG8_BAR __builtin_amdgcn_s_barrier()
#define PG8_SCHED __builtin_amdgcn_sched_barrier(0)
    Unit cur, nxt; int ui = 0;
    if (!S.next(0, cur)) return;
    Acc acc;
#pragma unroll
    for (int a = 0; a < 2; ++a)
#pragma unroll
        for (int b = 0; b < 2; ++b)
#pragma unroll
            for (int m = 0; m < 4; ++m)
#pragma unroll
                for (int n = 0; n < 2; ++n) acc[a][b][m][n] = (f32x4){0.f, 0.f, 0.f, 0.f};
    bf16x8 At[4][2], B0[2][2], B1[2][2];
    const char* cA = S.aptr(cur); const char* cB = S.bptr(cur);
    PG8_STAGE(PG8_SB(0, 0), cB, voffB); PG8_STAGE(PG8_SB(0, 1), cB + hstepB, voffB); PG8_STAGE(PG8_SA(0, 0), cA, voffA); PG8_STAGE(PG8_SA(0, 1), cA + hstepA, voffA);
    if (wr == 1) PG8_BAR;
    PG8_WAIT_V(2); PG8_BAR;
    PG8_STAGE(PG8_SB(1, 0), cB + kstep, voffB); PG8_STAGE(PG8_SA(1, 0), cA + kstep, voffA); PG8_STAGE(PG8_SB(1, 1), cB + hstepB + kstep, voffB);
    PG8_WAIT_V(6); PG8_BAR;
    for (;;) {
        const bool has_next = S.next(ui + 1, nxt);
        const char* nA = has_next ? S.aptr(nxt) : cA; const char* nB = has_next ? S.bptr(nxt) : cB;
        for (int t = 0; t < nt; t += 2) {
            const bool last = (t == nt - 2);
            const char* a1 = cA + (size_t)(t + 1) * kstep;
            const char* a2 = last ? nA : cA + (size_t)(t + 2) * kstep; const char* b2 = last ? nB : cB + (size_t)(t + 2) * kstep;
            const char* a3 = a2 + kstep; const char* b3 = b2 + kstep;
            PG8_LDB(B0, 0, 0); PG8_LDB(B1, 0, 1); PG8_SCHED; PG8_LDA(At, 0, 0); PG8_STAGE(PG8_SA(1, 1), a1 + hstepA, voffA);
            PG8_WAIT_V(8); PG8_WAIT_L(0); PG8_BAR; PG8_MMA(0, 0, At, B0); PG8_MMA(0, 1, At, B1); PG8_BAR; PG8_SCHED;
            PG8_LDA(At, 0, 1); PG8_STAGE(PG8_SB(0, 0), b2, voffB); PG8_STAGE(PG8_SB(0, 1), b2 + hstepB, voffB); PG8_STAGE(PG8_SA(0, 0), a2, voffA);
            PG8_WAIT_V(8); PG8_WAIT_L(0); PG8_BAR; PG8_MMA(1, 0, At, B0); PG8_MMA(1, 1, At, B1); PG8_BAR; PG8_SCHED;
            PG8_LDB(B0, 1, 0); PG8_LDB(B1, 1, 1); PG8_SCHED; PG8_LDA(At, 1, 0); PG8_STAGE(PG8_SA(0, 1), a2 + hstepA, voffA);
            PG8_WAIT_V(8); PG8_WAIT_L(0); PG8_BAR; PG8_MMA(0, 0, At, B0); PG8_MMA(0, 1, At, B1); PG8_BAR; PG8_SCHED;
            PG8_LDA(At, 1, 1); PG8_STAGE(PG8_SB(1, 0), b3, voffB); PG8_STAGE(PG8_SB(1, 1), b3 + hstepB, voffB); PG8_STAGE(PG8_SA(1, 0), a3, voffA);
            PG8_WAIT_V(8); PG8_WAIT_L(0); PG8_BAR; PG8_MMA(1, 0, At, B0); PG8_MMA(1, 1, At, B1); PG8_BAR; PG8_SCHED;
        }
        if (wr == 0) PG8_BAR;
        E(acc, cur, wr, wc, fr, fq);
        if (!has_next) break;
        if (!E.keep(cur)) {
#pragma unroll
            for (int a = 0; a < 2; ++a)
#pragma unroll
                for (int b = 0; b < 2; ++b)
#pragma unroll
                    for (int m = 0; m < 4; ++m)
#pragma unroll
                        for (int n = 0; n < 2; ++n) acc[a][b][m][n] = (f32x4){0.f, 0.f, 0.f, 0.f};
        }
        cur = nxt; cA = nA; cB = nB; ++ui;
        if (wr == 1) PG8_BAR;
    }
    PG8_WAIT_V(0);
    PG8_BAR;
#undef PG8_SA
#undef PG8_SB
#undef PG8_STAGE
#undef PG8_LDA
#undef PG8_LDB
#undef PG8_MMA
#undef PG8_WAIT_V
#undef PG8_WAIT_L
#undef PG8_BAR
#undef PG8_SCHED
}
}

namespace att {
constexpr int STG = 32768, L_TAB = 65536, L_WSF = L_TAB + 2048, L_END = L_WSF + 2048;
static_assert(L_END <= RING_BYTES, "attention LDS");
__device__ __forceinline__ int crow(int r, int hi) { return (r & 3) + 8 * (r >> 2) + 4 * hi; }
__device__ __forceinline__ s16x4 vtr(const LAS char* p) { return __builtin_bit_cast(s16x4, __builtin_amdgcn_ds_read_tr16_b64_v4i16((LAS s16x4*)p)); }
__device__ __forceinline__ int t5_bucket(int rel) {
    const int n = rel < 0 ? -rel : rel;
    const int large = 8 + (n >= 12) + (n >= 16) + (n >= 23) + (n >= 32) + (n >= 46) + (n >= 64) + (n >= 91);
    return (rel > 0 ? 16 : 0) + (n < 8 ? n : large);
}
struct Params {
    const bf16_t* QQ; const bf16_t *KA, *VA, *KB, *VB; bf16_t* Y;
    const float *relA, *t5, *lq1, *lk1, *lq2, *lk2, *subg;
};

template <int MODE>
__device__ __forceinline__ void unit(LAS char* lds, const Params& P, int b, int hp, int qb) {
    constexpr int NDB = MODE == 0 ? 2 : 4;
    const int tid = threadIdx.x, lane = tid & 63, r32 = lane & 31, hi = lane >> 5;
    const int w = __builtin_amdgcn_readfirstlane(tid >> 6), g = w >> 2, wq = w & 3;
    const bf16_t* Kslab = (MODE == 0 ? P.KA : P.KB) + (size_t)b * SEQ * 512 + hp * 128;
    const bf16_t* Vslab = (MODE == 0 ? P.VA : P.VB) + (size_t)b * SEQ * 512 + hp * 128;
    const int qcol = (MODE == 0 ? 0 : 512) + hp * 128;
    const int qrow0 = qb * 128 + wq * 32;
    const size_t grow0 = (size_t)b * SEQ + qrow0;
    const int cq = qrow0 >> 6;
    const int t_hi = 2 * qb + 1, t_lo = MODE == 0 ? (2 * qb - 8 > 0 ? 2 * qb - 8 : 0) : 0;
    const int w_lo = MODE == 0 ? cq - 8 : 0;
    LAS float* tab = (LAS float*)(lds + L_TAB);
    if (tid < 512) {
        const int gg = tid >> 8, idx = tid & 255, rel = idx - 191; float v;
        if (MODE == 0) { const float* tb = P.relA + (2 * hp + gg) * 257; const int rc = rel < -128 ? -128 : (rel > 128 ? 128 : rel); v = (tb[rc + 128] - tb[0]) * LOG2E; }
        else { const float* tb = P.t5 + hp * 32; v = (tb[t5_bucket(rel)] - tb[15]) * LOG2E; }
        tab[gg * 256 + idx] = v;
    }
    bf16x8 qf[4];
#pragma unroll
    for (int s = 0; s < 4; ++s) qf[s] = *(const bf16x8*)(P.QQ + (grow0 + r32) * 1024 + qcol + 64 * g + 16 * s + 8 * hi);
    const bf16_t* ksrc = Kslab + (size_t)lane * 512 + w * 8;
    const bf16_t* vsrc = Vslab + (size_t)(16 * (w & 3) + (lane >> 2)) * 512 + (w >> 2) * 32 + (lane & 3) * 8;
#define ATT_STAGE(t, boff) do { const size_t ro_ = (size_t)(t) * 64 * 512; \
        __builtin_amdgcn_global_load_lds((const unsigned*)(ksrc + ro_), (LAS unsigned*)(lds + (boff) + w * 1024), 16, 0, 0); \
        __builtin_amdgcn_global_load_lds((const unsigned*)(ksrc + ro_ + 64), (LAS unsigned*)(lds + (boff) + (w + 8) * 1024), 16, 0, 0); \
        __builtin_amdgcn_global_load_lds((const unsigned*)(vsrc + ro_), (LAS unsigned*)(lds + (boff) + 16384 + w * 1024), 16, 0, 0); \
        __builtin_amdgcn_global_load_lds((const unsigned*)(vsrc + ro_ + 64), (LAS unsigned*)(lds + (boff) + 16384 + (w + 8) * 1024), 16, 0, 0); } while (0)
    ATT_STAGE(t_lo, (t_lo & 1) * STG);
    f32x16 o[NDB];
#pragma unroll
    for (int d = 0; d < NDB; ++d) o[d] = (f32x16){};
    float mrun = -1e30f, lrun = 0.f;
    LAS float* wsf = (LAS float*)(lds + L_WSF) + w * 64;
    const int koff = (8 * g + hi) * 1024 + r32 * 16;
    const int voff = 16384 + (MODE == 0 ? 2 * g * 4096 : 0) + ((lane >> 4) & 1) * 32 + (lane & 3) * 8 + (4 * hi + ((lane & 15) >> 2)) * 64;
    asm volatile("s_waitcnt vmcnt(0)" ::: "memory"); __syncthreads();
    for (int t = t_lo; t <= t_hi; ++t) {
        const int boff = (t & 1) * STG;
        if (t < t_hi) ATT_STAGE(t + 1, ((t + 1) & 1) * STG);
        if (t >= w_lo && t <= cq) {
            const LAS char* kb = lds + boff + koff;
            f32x16 s0 = (f32x16){}, s1 = (f32x16){};
#pragma unroll
            for (int s = 0; s < 4; ++s) {
                const bf16x8 k0 = *(const LAS bf16x8*)(kb + s * 2048), k1 = *(const LAS bf16x8*)(kb + s * 2048 + 512);
                s0 = __builtin_amdgcn_mfma_f32_32x32x16_bf16(k0, qf[s], s0, 0, 0, 0); s1 = __builtin_amdgcn_mfma_f32_32x32x16_bf16(k1, qf[s], s1, 0, 0, 0);
            }
            if (t >= cq - 2) {
                const LAS float* tb = tab + (MODE == 0 ? g * 256 : 0) + (64 * t - (qrow0 + r32) + 191 + 4 * hi);
#pragma unroll
                for (int r = 0; r < 16; ++r) { s0[r] += tb[(r & 3) + 8 * (r >> 2)]; s1[r] += tb[32 + (r & 3) + 8 * (r >> 2)]; }
            }
            float rm = fmaxf(s0[0], s1[0]);
#pragma unroll
            for (int r = 1; r < 16; ++r) rm = fmaxf(rm, fmaxf(s0[r], s1[r]));
            rm = fmaxf(rm, __shfl_xor(rm, 32));
            if (__any(rm > mrun + 8.0f)) {
                const float mn = fmaxf(mrun, rm), al = fast_exp2(mrun - mn);
                lrun *= al; mrun = mn;
                if (hi == 0) wsf[r32] = al;
                __builtin_amdgcn_wave_barrier();
#pragma unroll
                for (int r = 0; r < 16; ++r) { const float f = wsf[crow(r, hi)];
#pragma unroll
                    for (int d = 0; d < NDB; ++d) o[d][r] *= f; }
                __builtin_amdgcn_wave_barrier();
            }
            float ls = 0.f;
#pragma unroll
            for (int r = 0; r < 16; ++r) { s0[r] = fast_exp2(s0[r] - mrun); s1[r] = fast_exp2(s1[r] - mrun); ls += s0[r] + s1[r]; }
            lrun += ls;
            bf16x8 pa[4];
            { u32x4 t0, t1, t2, t3;
              t0.x = cvt_pk_bf16(s0[0], s0[1]); t0.y = cvt_pk_bf16(s0[2], s0[3]); t0.z = cvt_pk_bf16(s0[4], s0[5]); t0.w = cvt_pk_bf16(s0[6], s0[7]);
              t1.x = cvt_pk_bf16(s0[8], s0[9]); t1.y = cvt_pk_bf16(s0[10], s0[11]); t1.z = cvt_pk_bf16(s0[12], s0[13]); t1.w = cvt_pk_bf16(s0[14], s0[15]);
              t2.x = cvt_pk_bf16(s1[0], s1[1]); t2.y = cvt_pk_bf16(s1[2], s1[3]); t2.z = cvt_pk_bf16(s1[4], s1[5]); t2.w = cvt_pk_bf16(s1[6], s1[7]);
              t3.x = cvt_pk_bf16(s1[8], s1[9]); t3.y = cvt_pk_bf16(s1[10], s1[11]); t3.z = cvt_pk_bf16(s1[12], s1[13]); t3.w = cvt_pk_bf16(s1[14], s1[15]);
              pa[0] = __builtin_bit_cast(bf16x8, t0); pa[1] = __builtin_bit_cast(bf16x8, t1); pa[2] = __builtin_bit_cast(bf16x8, t2); pa[3] = __builtin_bit_cast(bf16x8, t3); }
            const LAS char* vb = lds + boff + voff;
#pragma unroll
            for (int d = 0; d < NDB; ++d)
#pragma unroll
                for (int ks = 0; ks < 4; ++ks) {
                    const s16x4 lo = vtr(vb + d * 4096 + ks * 1024), hh = vtr(vb + d * 4096 + ks * 1024 + 512);
                    const bf16x8 vf = {lo[0], lo[1], lo[2], lo[3], hh[0], hh[1], hh[2], hh[3]};
                    o[d] = __builtin_amdgcn_mfma_f32_32x32x16_bf16(pa[ks], vf, o[d], 0, 0, 0);
                }
        }
        asm volatile("s_waitcnt vmcnt(0)" ::: "memory"); __syncthreads();
    }
#undef ATT_STAGE
    const float lt = lrun + __shfl_xor(lrun, 32);
    if (hi == 0) wsf[32 + r32] = fast_rcp(lt);
    __builtin_amdgcn_wave_barrier();
    float inv[16];
#pragma unroll
    for (int r = 0; r < 16; ++r) inv[r] = wsf[32 + crow(r, hi)];
    if (MODE == 0) {
        bf16_t* yo = P.Y + grow0 * 1024 + qcol + 64 * g + r32;
#pragma unroll
        for (int r = 0; r < 16; ++r)
#pragma unroll
            for (int d = 0; d < NDB; ++d) yo[(size_t)crow(r, hi) * 1024 + 32 * d] = (bf16_t)(cvt_pk_bf16(o[d][r] * inv[r], 0.f) & 0xffffu);
        __syncthreads();
    } else {
        const float s1 = wave_sum(P.lq1[lane] * P.lk1[lane]), s2 = wave_sum(P.lq2[lane] * P.lk2[lane]);
        const float lam = __expf(s1) - __expf(s2) + 0.2f;
        LAS float* X = (LAS float*)lds;
        if (g == 1) {
#pragma unroll
            for (int r = 0; r < 16; ++r)
#pragma unroll
                for (int d = 0; d < 4; ++d) X[((wq * 16 + r) * 4 + d) * 64 + lane] = o[d][r] * inv[r] * lam;
        }
        __syncthreads();
        if (g == 0) {
            float sg[4];
#pragma unroll
            for (int d = 0; d < 4; ++d) sg[d] = P.subg[32 * d + r32] * 0.8f;
            bf16_t* yo = P.Y + grow0 * 1024 + qcol + r32;
#pragma unroll
            for (int r = 0; r < 16; ++r) {
                float dv[4]; float ss = 0.f;
#pragma unroll
                for (int d = 0; d < 4; ++d) { dv[d] = o[d][r] * inv[r] - X[((wq * 16 + r) * 4 + d) * 64 + lane]; ss += dv[d] * dv[d]; }
                ss += __shfl_xor(ss, 1); ss += __shfl_xor(ss, 2); ss += __shfl_xor(ss, 4); ss += __shfl_xor(ss, 8); ss += __shfl_xor(ss, 16);
                const float rn = __builtin_amdgcn_rsqf(ss * (1.0f / 128.0f) + EPS);
#pragma unroll
                for (int d = 0; d < 4; ++d) yo[(size_t)crow(r, hi) * 1024 + 32 * d] = (bf16_t)(cvt_pk_bf16(dv[d] * rn * sg[d], 0.f) & 0xffffu);
            }
        }
        __syncthreads();
    }
}
}

typedef GAS unsigned gu32;
#define XB_TMO      128
#define XB_XCNT(j)  (256  + 64 * (j))
#define XB_XSUB(j)  (1280 + 64 * (j))
#define XB_XGEN(j)  (2304 + 64 * (j))
#define XB_TOP      3328
#define XB_TOPGEN   3392
#define XCD_BAR_WORDS 3456
#define XB_SPIN_CAP (1u << 18)
__device__ __forceinline__ unsigned xb_ld(unsigned* p)              { return __hip_atomic_load(p, __ATOMIC_RELAXED, __HIP_MEMORY_SCOPE_AGENT); }
__device__ __forceinline__ unsigned xb_add(unsigned* p, unsigned v) { return __hip_atomic_fetch_add(p, v, __ATOMIC_RELAXED, __HIP_MEMORY_SCOPE_AGENT); }
__device__ __forceinline__ unsigned xb_xcc_id() { return (unsigned)__builtin_amdgcn_s_getreg((3 << 11) | 20) & 0xFu; }
#define XB_SPIN(cond, bar) do { unsigned _sp = 0; while (cond) { __builtin_amdgcn_s_sleep(1); \
    if ((++_sp & 255u) == 0u) { if (xb_ld(&(bar)[XB_TMO])) break; if (_sp > XB_SPIN_CAP) { atomicAdd(&(bar)[XB_TMO], 1u); break; } } } } while (0)
struct XcdBarrier { unsigned* bar; unsigned x; volatile LAS unsigned* st; };
__device__ __forceinline__ XcdBarrier xcd_barrier_post(unsigned* bar, volatile LAS unsigned* st) {
    XcdBarrier b; b.bar = bar; b.x = xb_xcc_id(); b.st = st;
    if (threadIdx.x == 0) (void)xb_add(&bar[XB_XCNT(b.x)], 1u);
    return b;
}
__device__ __forceinline__ void xcd_barrier_complete(unsigned* bar, unsigned x, unsigned& nloc, unsigned& nx) {
    const unsigned G = gridDim.x * gridDim.y * gridDim.z;
    unsigned sum, cnt, mine, sp = 0u;
    for (;;) {
        sum = 0u; cnt = 0u; mine = 0u;
#pragma unroll
        for (unsigned j = 0; j < 16; ++j) { const unsigned c = xb_ld(&bar[XB_XCNT(j)]); sum += c; cnt += (c > 0u) ? 1u : 0u; mine = (j == x) ? c : mine; }
        if (sum == G) break;
        __builtin_amdgcn_s_sleep(1);
        if ((++sp & 255u) == 0u) { if (xb_ld(&bar[XB_TMO])) break; if (sp > XB_SPIN_CAP) { atomicAdd(&bar[XB_TMO], 1u); break; } }
    }
    nloc = mine > 0u ? mine : 1u; nx = cnt > 0u ? cnt : 1u;
}
__device__ __forceinline__ void xcd_barrier(const XcdBarrier& b) {
    asm volatile("s_waitcnt vmcnt(0)" ::: "memory");
    __syncthreads();
    if (threadIdx.x == 0) {
        unsigned* bar = b.bar;
        __builtin_amdgcn_s_waitcnt(0);
        unsigned nloc = b.st[0], nx = b.st[1];
        if (nloc == 0u) { xcd_barrier_complete(bar, b.x, nloc, nx); b.st[0] = nloc; b.st[1] = nx; }
        const unsigned old = xb_add(&bar[XB_XSUB(b.x)], 1u);
        const unsigned gen = old / nloc;
        if (old + 1u == (gen + 1u) * nloc) {
            __builtin_amdgcn_fence(__ATOMIC_RELEASE, "agent");
            asm volatile("s_waitcnt vmcnt(0)" ::: "memory");
            const unsigned og = xb_add(&bar[XB_TOP], 1u);
            const unsigned tg = og / nx;
            if (og + 1u == (tg + 1u) * nx) xb_add(&bar[XB_TOPGEN], 1u);
            else XB_SPIN(xb_ld(&bar[XB_TOPGEN]) == tg, bar);
            __builtin_amdgcn_fence(__ATOMIC_ACQUIRE, "agent");
            xb_add(&bar[XB_XGEN(b.x)], 1u);
            asm volatile("s_waitcnt vmcnt(0)" ::: "memory");
        } else {
            XB_SPIN(xb_ld(&bar[XB_XGEN(b.x)]) == gen, bar);
            __builtin_amdgcn_fence(__ATOMIC_ACQUIRE, "agent");
            asm volatile("s_waitcnt vmcnt(0)" ::: "memory");
        }
    }
    __syncthreads();
}

__device__ __forceinline__ unsigned f2bf(float f) { unsigned u = __builtin_bit_cast(unsigned, f); return (u + 0x7fffu + ((u >> 16) & 1u)) >> 16; }
__device__ __forceinline__ unsigned pk2(float lo, float hi) { return f2bf(lo) | (f2bf(hi) << 16); }
template <bool SWI, bool GAIN>
__device__ __forceinline__ void p0_transpose_item(const float* W, int K, int N, const float* gain, bf16_t* WT, LAS float* scr, int item, int lane) {
    const int nblk = N / 32, kb = item / nblk, nb = item % nblk, k0 = 64 * kb, n0 = 32 * nb;
#pragma unroll 8
    for (int i = 0; i < 32; ++i) { const int kk = 2 * i + (lane >> 5); const float gk = GAIN ? gain[k0 + kk] : 1.0f; scr[kk * 33 + (lane & 31)] = W[(size_t)(k0 + kk) * N + n0 + (lane & 31)] * gk; }
    asm volatile("s_waitcnt lgkmcnt(0)" ::: "memory");
    int r0 = n0;
    if (SWI) { const int half = n0 >= DFF, nn = n0 - half * DFF; r0 = (nn >> 7) * 256 + half * 128 + (nn & 127); }
    const int c = lane & 7;
#pragma unroll
    for (int j = 0; j < 4; ++j) { const int n = (lane >> 3) + 8 * j; const LAS float* s = scr + (8 * c) * 33 + n;
        u32x4 o; o.x = pk2(s[0 * 33], s[1 * 33]); o.y = pk2(s[2 * 33], s[3 * 33]); o.z = pk2(s[4 * 33], s[5 * 33]); o.w = pk2(s[6 * 33], s[7 * 33]);
        *(GAS u32x4*)(WT + (size_t)(r0 + n) * K + k0 + 8 * c) = o; }
    asm volatile("s_waitcnt lgkmcnt(0)" ::: "memory");
}

constexpr int N_PHASES = 10;
struct Args { const float* in[21]; float* out; unsigned char* ws; int ph_lo, ph_hi; };
static_assert(sizeof(Args) == 21 * 8 + 8 + 8 + 8, "Args has no padding");

__global__ void __launch_bounds__(NWAVES * 64, 2) fwd_kernel(Args args) {
    extern __shared__ __attribute__((aligned(16))) unsigned char lds_raw[];
    LAS unsigned char* lds = (LAS unsigned char*)lds_raw;
    volatile LAS unsigned* MISC = (volatile LAS unsigned*)(lds + MISC_OFF);
    const int tid = threadIdx.x, lane = tid & 63, wave = __builtin_amdgcn_readfirstlane(tid >> 6);
    const int G = gridDim.x, bx = blockIdx.x;
    const int vcu = (G % 8 == 0) ? (bx % 8) * (G / 8) + bx / 8 : bx;
    unsigned char* ws = args.ws;
    const float* x = args.in[0]; const float* g_ffn1 = args.in[1]; const float* w_in1 = args.in[2]; const float* w_out1 = args.in[3];
    const float* g_mix = args.in[4]; const float* w_mix = args.in[5]; const float* b_gate = args.in[6]; const float* rel_a = args.in[7];
    const float* lq1 = args.in[8]; const float* lk1 = args.in[9]; const float* lq2 = args.in[10]; const float* lk2 = args.in[11];
    const float* subg = args.in[12]; const float* t5 = args.in[13]; const float* w_a = args.in[14]; const float* w_b = args.in[15];
    const float* w_o = args.in[16]; const float* g_ffn2 = args.in[17]; const float* w_in2 = args.in[18]; const float* w_out2 = args.in[19]; const float* g_fin = args.in[20];
    float* out = args.out;
    float* SSQ0 = (float*)(ws + WS_SSQ0); float* SSQ1 = (float*)(ws + WS_SSQ1); float* SSQ2 = (float*)(ws + WS_SSQ2); float* SSQ3 = (float*)(ws + WS_SSQ3);
    bf16_t* WIN1 = (bf16_t*)(ws + WS_WIN1); bf16_t* WOUT1 = (bf16_t*)(ws + WS_WOUT1); bf16_t* WMIX = (bf16_t*)(ws + WS_WMIX); bf16_t* WA = (bf16_t*)(ws + WS_WA);
    bf16_t* WB = (bf16_t*)(ws + WS_WB); bf16_t* WO = (bf16_t*)(ws + WS_WO); bf16_t* WIN2 = (bf16_t*)(ws + WS_WIN2); bf16_t* WOUT2 = (bf16_t*)(ws + WS_WOUT2);
    bf16_t* XB = (bf16_t*)(ws + WS_XB); bf16_t* HB = (bf16_t*)(ws + WS_H);
    bf16_t* QQ = (bf16_t*)(ws + WS_QQ); bf16_t* KA = (bf16_t*)(ws + WS_KA); bf16_t* VA = (bf16_t*)(ws + WS_VA); bf16_t* KB = (bf16_t*)(ws + WS_KB); bf16_t* VB = (bf16_t*)(ws + WS_VB);
    bf16_t* GA = (bf16_t*)(ws + WS_GA); bf16_t* GB = (bf16_t*)(ws + WS_GB); bf16_t* MG = (bf16_t*)(ws + WS_MG);

    for (int u = tid; u < (LDS_BYTES - LDSCTL_OFF) / 4; u += NWAVES * 64) ((LAS unsigned*)(lds + LDSCTL_OFF))[u] = 0u;
    __syncthreads();
    const int lo = args.ph_lo, hi = args.ph_hi;
    const bool one_launch = (hi - lo) > 1;
    XcdBarrier bar; bar.bar = (unsigned*)(ws + WS_CTL) + CW_BAR; bar.x = 0; bar.st = nullptr;
    if (one_launch) bar = xcd_barrier_post((unsigned*)(ws + WS_CTL) + CW_BAR, MISC + 8);
#define IN(k) (lo <= (k) && (k) < hi)
#define SEAM(k) do { if (IN(k) && IN((k) + 1)) { if ((k) == 0) { cg::this_grid().sync(); } else { xcd_barrier(bar); } } } while (0)

    if (IN(0)) {
        LAS float* scr = (LAS float*)(lds + wave * 16384);
        const int gw = vcu * NWAVES + wave, NGW = G * NWAVES;
        constexpr int I_IN = (DM / 64) * (NFF / 32), I_OUT = (DFF / 64) * (DM / 32), I_MIX = (DM / 64) * (NMIX / 32), I_BR = (512 / 64) * (DM / 32), I_O = (DM / 64) * (DM / 32);
        constexpr int NITEMS = 2 * I_IN + 2 * I_OUT + I_MIX + 2 * I_BR + I_O;
        for (int it = gw; it < NITEMS; it += NGW) {
            int r = it;
            if (r < I_IN) { p0_transpose_item<true, true>(w_in1, DM, NFF, g_ffn1, WIN1, scr, r, lane); continue; } r -= I_IN;
            if (r < I_IN) { p0_transpose_item<true, true>(w_in2, DM, NFF, g_ffn2, WIN2, scr, r, lane); continue; } r -= I_IN;
            if (r < I_OUT) { p0_transpose_item<false, false>(w_out1, DFF, DM, nullptr, WOUT1, scr, r, lane); continue; } r -= I_OUT;
            if (r < I_OUT) { p0_transpose_item<false, false>(w_out2, DFF, DM, nullptr, WOUT2, scr, r, lane); continue; } r -= I_OUT;
            if (r < I_MIX) { p0_transpose_item<false, true>(w_mix, DM, NMIX, g_mix, WMIX, scr, r, lane); continue; } r -= I_MIX;
            if (r < I_BR) { p0_transpose_item<false, false>(w_a, 512, DM, nullptr, WA, scr, r, lane); continue; } r -= I_BR;
            if (r < I_BR) { p0_transpose_item<false, false>(w_b, 512, DM, nullptr, WB, scr, r, lane); continue; } r -= I_BR;
            p0_transpose_item<false, false>(w_o, DM, DM, nullptr, WO, scr, r, lane);
        }
        for (int m = gw; m < M; m += NGW) {
            const GAS f32x4* xr = (const GAS f32x4*)(x + (size_t)m * DM) + lane;
            f32x4 v[4]; float s = 0.f;
#pragma unroll
            for (int j = 0; j < 4; ++j) { v[j] = xr[64 * j]; s += (v[j].x * v[j].x + v[j].y * v[j].y) + (v[j].z * v[j].z + v[j].w * v[j].w); }
            s = wave_sum(s);
            GAS u32x2* o8 = (GAS u32x2*)(XB + (size_t)m * DM) + lane;
#pragma unroll
            for (int j = 0; j < 4; ++j) { u32x2 wv; wv.x = cvt_pk_bf16(v[j].x, v[j].y); wv.y = cvt_pk_bf16(v[j].z, v[j].w); o8[64 * j] = wv; }
            if (lane < 16) SSQ0[(size_t)m * 16 + lane] = lane == 0 ? s : 0.f;
        }
    }
    SEAM(0);
    if (IN(1)) {
        pg8::Gemm g{DM, DM, DM}; pg8::StaticOrder S{XB, WIN1, DM, DM, M / 256, NFF / 256, G, bx};
        pg8::EpiSwiglu E{HB, SSQ0};
        pg8::gemm_phase(lds, g, S, E);
    }
    SEAM(1);
    if (IN(2)) {
        pg8::Gemm g{DFF, DFF, DFF}; pg8::StaticOrder S{HB, WOUT1, DFF, DFF, M / 256, DM / 256, G, bx};
        pg8::EpiResid E{x, out, XB, SSQ1, 0.5f};
        pg8::gemm_phase(lds, g, S, E);
    }
    SEAM(2);
    if (IN(3)) {
        pg8::Gemm g{DM, DM, DM}; pg8::StaticOrder S{XB, WMIX, DM, DM, M / 256, NMIX / 256, G, bx};
        pg8::EpiMix E{QQ, KA, VA, KB, VB, GA, GB, SSQ1, b_gate};
        pg8::gemm_phase(lds, g, S, E);
    }
    SEAM(3);
    if (IN(4)) {
        att::Params P{QQ, KA, VA, KB, VB, QQ, rel_a, t5, lq1, lk1, lq2, lk2, subg};
        for (int v = vcu; v < 256; v += G) {
            const int bh = v >> 3, j = v & 7, b = bh >> 2, hp = bh & 3;
            att::unit<1>((LAS char*)lds, P, b, hp, 15 - j);
            att::unit<0>((LAS char*)lds, P, b, hp, 15 - j);
            att::unit<1>((LAS char*)lds, P, b, hp, j);
            att::unit<0>((LAS char*)lds, P, b, hp, j);
        }
    }
    SEAM(4);
    if (IN(5)) {
        pg8::Gemm g{DM, 512, 512}; pg8::BranchOrder S{QQ, QQ + 512, WA, WB, DM, 512, M / 256, DM / 256, G, bx};
        pg8::EpiBranch E{GA, GB, MG};
        pg8::gemm_phase(lds, g, S, E);
    }
    SEAM(5);
    if (IN(6)) {
        pg8::Gemm g{DM, DM, DM}; pg8::StaticOrder S{MG, WO, DM, DM, M / 256, DM / 256, G, bx};
        pg8::EpiResid E{out, out, XB, SSQ2, 1.0f};
        pg8::gemm_phase(lds, g, S, E);
    }
    SEAM(6);
    if (IN(7)) {
        pg8::Gemm g{DM, DM, DM}; pg8::StaticOrder S{XB, WIN2, DM, DM, M / 256, NFF / 256, G, bx};
        pg8::EpiSwiglu E{HB, SSQ2};
        pg8::gemm_phase(lds, g, S, E);
    }
    SEAM(7);
    if (IN(8)) {
        pg8::Gemm g{DFF, DFF, DFF}; pg8::StaticOrder S{HB, WOUT2, DFF, DFF, M / 256, DM / 256, G, bx};
        pg8::EpiResid E{out, out, nullptr, SSQ3, 0.5f};
        pg8::gemm_phase(lds, g, S, E);
    }
    SEAM(8);
    if (IN(9)) {
        const int gw = vcu * NWAVES + wave, NGW = G * NWAVES;
        f32x4 gv[4];
#pragma unroll
        for (int j = 0; j < 4; ++j) gv[j] = ((const f32x4*)g_fin)[lane + 64 * j];
        for (int m = gw; m < M; m += NGW) {
            const float rs = row_rstd(SSQ3, m);
            f32x4* xr = (f32x4*)(out + (size_t)m * DM) + lane;
#pragma unroll
            for (int j = 0; j < 4; ++j) { const f32x4 v = xr[64 * j]; xr[64 * j] = v * rs * gv[j]; }
        }
    }
#undef IN
#undef SEAM
}

extern "C" void kernel_launch(void* const* d_in, const int* in_sizes, int n_in, void* d_out, int out_size, void* d_ws, size_t ws_size, hipStream_t stream) {
    static int grid = 0;
    if (grid == 0) {
        if (n_in != 21 || in_sizes[0] != M * DM || out_size != M * DM || ws_size < WS_END) { fprintf(stderr, "kernel_launch: unexpected shapes (n_in %d, in0 %d, out %d, ws %zu); nothing launched\n", n_in, n_in > 0 ? in_sizes[0] : -1, out_size, ws_size); grid = -1; return; }
        int dev = 0, cus = 0, per_cu = 0;
        if (hipGetDevice(&dev) != hipSuccess || hipDeviceGetAttribute(&cus, hipDeviceAttributeMultiprocessorCount, dev) != hipSuccess) { fprintf(stderr, "kernel_launch: device query failed\n"); grid = -1; return; }
        if (hipFuncSetAttribute((const void*)fwd_kernel, hipFuncAttributeMaxDynamicSharedMemorySize, LDS_BYTES) != hipSuccess) { fprintf(stderr, "kernel_launch: hipFuncSetAttribute failed\n"); grid = -1; return; }
        if (hipOccupancyMaxActiveBlocksPerMultiprocessor(&per_cu, (const void*)fwd_kernel, NWAVES * 64, LDS_BYTES) != hipSuccess || per_cu < 1) { fprintf(stderr, "kernel_launch: occupancy query says %d blocks per CU\n", per_cu); per_cu = 1; }
        (void)hipGetLastError();
        grid = cus;
    }
    if (grid < 0) return;
    if (hipMemsetAsync((char*)d_ws + WS_CTL, 0, CTL_ZERO_BYTES, stream) != hipSuccess) { fprintf(stderr, "kernel_launch: hipMemsetAsync failed\n"); return; }
    Args a{};
    for (int i = 0; i < 21; ++i) a.in[i] = (const float*)d_in[i];
    a.out = (float*)d_out; a.ws = (unsigned char*)d_ws;
#if MK_N_LAUNCHES == 1
    a.ph_lo = 0; a.ph_hi = N_PHASES;
    void* kargs[] = {&a};
    hipError_t e = hipLaunchCooperativeKernel((const void*)fwd_kernel, dim3(grid), dim3(NWAVES * 64), kargs, LDS_BYTES, stream);
    if (e != hipSuccess) fprintf(stderr, "kernel_launch: cooperative launch failed: %s (grid %d)\n", hipGetErrorString(e), grid);
#else
    for (int p = 0; p < N_PHASES; ++p) {
        a.ph_lo = p; a.ph_hi = p + 1;
        hipLaunchKernelGGL(fwd_kernel, dim3(grid), dim3(NWAVES * 64), LDS_BYTES, stream, a);
    }
#endif
}
```

```cpp
#include <hip/hip_runtime.h>
#include <hip/hip_cooperative_groups.h>
#include <cstdio>
#include <cstdint>
namespace cg = cooperative_groups;

#ifndef MK_N_LAUNCHES
#define MK_N_LAUNCHES 1
#endif

#define LAS __attribute__((address_space(3)))
#define GAS __attribute__((address_space(1)))
typedef unsigned short bf16_t;
typedef short bf16x8 __attribute__((ext_vector_type(8)));
typedef short s16x4 __attribute__((ext_vector_type(4)));
typedef float f32x4 __attribute__((ext_vector_type(4)));
typedef float f32x16 __attribute__((ext_vector_type(16)));
typedef float f32x2 __attribute__((ext_vector_type(2)));
typedef unsigned u32x4 __attribute__((ext_vector_type(4)));
typedef unsigned u32x2 __attribute__((ext_vector_type(2)));
typedef __bf16 bf16x2_t __attribute__((ext_vector_type(2)));

constexpr int BATCH = 8, SEQ = 2048, DM = 1024, M = BATCH * SEQ;
constexpr int DFF = 2816, NFF = 2 * DFF, NMIX = 5120;
constexpr float EPS = 1e-6f;
constexpr float LOG2E = 1.4426950408889634f;
constexpr float QSCALE = 0.125f * LOG2E;
constexpr int NWAVES = 8;

constexpr size_t MiB = 1u << 20;
constexpr size_t WS_CTL = 0, CTL_ZERO_BYTES = 64 * 1024;
constexpr size_t WS_SSQ0 = 1 * MiB, WS_SSQ1 = 2 * MiB, WS_SSQ2 = 3 * MiB, WS_SSQ3 = 4 * MiB;
constexpr size_t WS_WIN1 = 5 * MiB, WS_WOUT1 = 16 * MiB, WS_WMIX = 22 * MiB, WS_WA = 32 * MiB, WS_WB = 33 * MiB, WS_WO = 34 * MiB, WS_WIN2 = 36 * MiB, WS_WOUT2 = 47 * MiB;
constexpr size_t WS_XB = 53 * MiB;
constexpr size_t WS_R = 85 * MiB;
constexpr size_t WS_H = WS_R;
constexpr size_t WS_QQ = WS_R, WS_KA = WS_R + 32 * MiB, WS_VA = WS_R + 48 * MiB, WS_KB = WS_R + 64 * MiB, WS_VB = WS_R + 80 * MiB, WS_GA = WS_R + 96 * MiB, WS_GB = WS_R + 128 * MiB;
constexpr size_t WS_MG = WS_KA;
constexpr size_t WS_END = WS_R + 160 * MiB;
static_assert(WS_END <= 256 * MiB, "d_ws map");
static_assert(WS_WOUT2 + (size_t)DM * DFF * 2 <= WS_XB && WS_XB + (size_t)M * DM * 2 <= WS_R && WS_H + (size_t)M * DFF * 2 <= WS_END, "d_ws map");
constexpr int CW_BAR = 1024;

constexpr int RING_BYTES = 131072;
constexpr int LDSCTL_OFF = RING_BYTES, MISC_OFF = LDSCTL_OFF + 320;
constexpr int LDS_BYTES = 147456;

__device__ __forceinline__ unsigned cvt_pk_bf16(float lo, float hi) { f32x2 v = {lo, hi}; bf16x2_t b = __builtin_convertvector(v, bf16x2_t); return __builtin_bit_cast(unsigned, b); }
__device__ __forceinline__ float bf16lo(unsigned w) { return __uint_as_float(w << 16); }
__device__ __forceinline__ float bf16hi(unsigned w) { return __uint_as_float(w & 0xffff0000u); }
__device__ __forceinline__ float fast_rcp(float x) { return __builtin_amdgcn_rcpf(x); }
__device__ __forceinline__ float fast_exp2(float x) { return __builtin_amdgcn_exp2f(x); }
__device__ __forceinline__ float sigmoidf_(float v) { return fast_rcp(1.0f + fast_exp2(-v * LOG2E)); }
__device__ __forceinline__ float wave_sum(float v) {
#pragma unroll
    for (int o = 1; o < 64; o <<= 1) v += __shfl_xor(v, o);
    return v;
}
__device__ __forceinline__ float row_rstd(const float* ssq, int row) {
    const f32x4* p = (const f32x4*)(ssq + (size_t)row * 16);
    const f32x4 a = p[0], b = p[1], c = p[2], d = p[3];
    const float s = (((a.x + a.y) + (a.z + a.w)) + ((b.x + b.y) + (b.z + b.w))) + (((c.x + c.y) + (c.z + c.w)) + ((d.x + d.y) + (d.z + d.w)));
    return __builtin_amdgcn_rsqf(s * (1.0f / DM) + EPS);
}

namespace pg8 {
constexpr int BM = 256, BK = 64, HALF = 128, HTB = HALF * BK * 2, STAGE_BYTES = 8 * HTB, NXCD = 8, WGM = 8;
__host__ __device__ __forceinline__ int lds_byte(int r, int c) { const int st = (r >> 4) * 2 + (c >> 5), rr = r & 15, cc = c & 31, ob = rr * 64 + cc * 2; return st * 1024 + (ob ^ (((ob >> 9) & 1) << 5)); }
__host__ __device__ __forceinline__ void stage_rc(int b, int& R, int& C) { const int st = b / 1024, sb = b % 1024, swz = sb ^ (((sb >> 9) & 1) << 5); R = (st >> 1) * 16 + swz / 64; C = (st & 1) * 32 + (swz % 64) / 2; }
__host__ __device__ __forceinline__ int perm32(int rho) { const int n = rho >> 4, i = rho & 15; return 8 * (i >> 2) + 4 * n + (i & 3); }

struct Unit { int pm, pn, aux; };
struct Gemm { int lda, ldb, K; };

__device__ __forceinline__ void tile_of(int L, int nM, int nN, int& pm, int& pn) {
    const int nwg = nM * nN; int wgid = L;
    { const int q = nwg / NXCD, r = nwg % NXCD, xcd = wgid % NXCD, off = wgid / NXCD; wgid = (xcd < r ? xcd * (q + 1) : r * (q + 1) + (xcd - r) * q) + off; }
    const int nig = WGM * nN, gid = wgid / nig, fm = gid * WGM, gsz = (nM - fm) < WGM ? (nM - fm) : WGM;
    pm = fm + ((wgid % nig) % gsz); pn = (wgid % nig) / gsz;
}
struct StaticOrder {
    const bf16_t* A; const bf16_t* Bt; int lda, ldb, nM, nN, G, c;
    __device__ __forceinline__ bool next(int i, Unit& u) const { const long L = (long)i * G + c; if (L >= (long)nM * nN) return false; tile_of((int)L, nM, nN, u.pm, u.pn); u.aux = 0; return true; }
    __device__ __forceinline__ const char* aptr(const Unit& u) const { return (const char*)(A + (size_t)u.pm * BM * lda); }
    __device__ __forceinline__ const char* bptr(const Unit& u) const { return (const char*)(Bt + (size_t)u.pn * BM * ldb); }
};
struct BranchOrder {
    const bf16_t *A0, *A1, *B0, *B1; int lda, ldb, nM, nN, G, c;
    __device__ __forceinline__ bool next(int i, Unit& u) const { const long L = (long)(i >> 1) * G + c; if (L >= (long)nM * nN) return false; tile_of((int)L, nM, nN, u.pm, u.pn); u.aux = i & 1; return true; }
    __device__ __forceinline__ const char* aptr(const Unit& u) const { return (const char*)((u.aux ? A1 : A0) + (size_t)u.pm * BM * lda); }
    __device__ __forceinline__ const char* bptr(const Unit& u) const { return (const char*)((u.aux ? B1 : B0) + (size_t)u.pn * BM * ldb); }
};

typedef f32x4 Acc[2][2][4][2];

struct EpiSwiglu {
    static constexpr bool PERM = true;
    bf16_t* H; const float* ssq;
    __device__ __forceinline__ bool keep(const Unit&) const { return false; }
    __device__ __forceinline__ void operator()(Acc& acc, const Unit& u, int wr, int wc, int fr, int fq) const {
#pragma unroll
        for (int ai = 0; ai < 2; ++ai)
#pragma unroll
            for (int m = 0; m < 4; ++m) {
                const int row = u.pm * BM + ai * HALF + wr * 64 + m * 16 + fr; const float rs = row_rstd(ssq, row);
                float h[8];
#pragma unroll
                for (int n = 0; n < 2; ++n)
#pragma unroll
                    for (int e = 0; e < 4; ++e) { const float g = acc[ai][0][m][n][e] * rs, up = acc[ai][1][m][n][e] * rs; h[n * 4 + e] = g * sigmoidf_(g) * up; }
                u32x4 w; w.x = cvt_pk_bf16(h[0], h[1]); w.y = cvt_pk_bf16(h[2], h[3]); w.z = cvt_pk_bf16(h[4], h[5]); w.w = cvt_pk_bf16(h[6], h[7]);
                *(u32x4*)(H + (size_t)row * DFF + u.pn * HALF + wc * 32 + 8 * fq) = w;
            }
    }
};
struct EpiResid {
    static constexpr bool PERM = false;
    const float* base; float* out; bf16_t* xb; float* ssq; float alpha;
    __device__ __forceinline__ bool keep(const Unit&) const { return false; }
    __device__ __forceinline__ void operator()(Acc& acc, const Unit& u, int wr, int wc, int fr, int fq) const {
        const int col0 = u.pn * BM + wc * 32 + 4 * fq;
#pragma unroll
        for (int ai = 0; ai < 2; ++ai)
#pragma unroll
            for (int m = 0; m < 4; ++m) {
                const int row = u.pm * BM + ai * HALF + wr * 64 + m * 16 + fr; const size_t off = (size_t)row * DM + col0; float s = 0.f;
#pragma unroll
                for (int bj = 0; bj < 2; ++bj)
#pragma unroll
                    for (int n = 0; n < 2; ++n) {
                        const f32x4 bs = *(const f32x4*)(base + off + bj * HALF + n * 16); const f32x4 v = bs + acc[ai][bj][m][n] * alpha;
                        *(f32x4*)(out + off + bj * HALF + n * 16) = v; s += (v.x * v.x + v.y * v.y) + (v.z * v.z + v.w * v.w);
                        if (xb) { u32x2 w; w.x = cvt_pk_bf16(v.x, v.y); w.y = cvt_pk_bf16(v.z, v.w); *(u32x2*)(xb + off + bj * HALF + n * 16) = w; }
                    }
                s += __shfl_xor(s, 16); s += __shfl_xor(s, 32);
                if (fq == 0) ssq[(size_t)row * 16 + u.pn * 4 + wc] = s;
            }
    }
};
struct EpiMix {
    static constexpr bool PERM = true;
    bf16_t *QQ, *KA, *VA, *KB, *VB, *GA, *GB; const float* ssq; const float* bgate;
    __device__ __forceinline__ bool keep(const Unit&) const { return false; }
    __device__ __forceinline__ void operator()(Acc& acc, const Unit& u, int wr, int wc, int fr, int fq) const {
        const int pn = u.pn; bf16_t* dst; int ld; float sc = 1.f; bool gate = false; int gcol = 0;
        if (pn < 2) { dst = QQ + pn * 256; ld = 1024; sc = QSCALE; }
        else if (pn < 4) { dst = KA + (pn - 2) * 256; ld = 512; }
        else if (pn < 6) { dst = VA + (pn - 4) * 256; ld = 512; }
        else if (pn < 8) { dst = QQ + 512 + (pn - 6) * 256; ld = 1024; sc = QSCALE; }
        else if (pn < 10) { dst = KB + (pn - 8) * 256; ld = 512; }
        else if (pn < 12) { dst = VB + (pn - 10) * 256; ld = 512; }
        else if (pn < 16) { dst = GA + (pn - 12) * 256; ld = 1024; gate = true; gcol = (pn - 12) * 256; }
        else { dst = GB + (pn - 16) * 256; ld = 1024; gate = true; gcol = (pn - 12) * 256; }
        const int cw = wc * 32 + 8 * fq;
        f32x4 bv[2][2];
#pragma unroll
        for (int bj = 0; bj < 2; ++bj)
#pragma unroll
            for (int n = 0; n < 2; ++n) bv[bj][n] = gate ? *(const f32x4*)(bgate + gcol + bj * HALF + cw + 4 * n) : (f32x4){0.f, 0.f, 0.f, 0.f};
#pragma unroll
        for (int ai = 0; ai < 2; ++ai)
#pragma unroll
            for (int m = 0; m < 4; ++m) {
                const int row = u.pm * BM + ai * HALF + wr * 64 + m * 16 + fr; const float rs = row_rstd(ssq, row) * sc;
                bf16_t* rowp = dst + (size_t)row * ld + cw;
#pragma unroll
                for (int bj = 0; bj < 2; ++bj) {
                    f32x4 v0 = acc[ai][bj][m][0] * rs, v1 = acc[ai][bj][m][1] * rs;
                    if (gate) {
                        v0 = v0 + bv[bj][0]; v1 = v1 + bv[bj][1];
                        v0 = (f32x4){sigmoidf_(v0.x), sigmoidf_(v0.y), sigmoidf_(v0.z), sigmoidf_(v0.w)}; v1 = (f32x4){sigmoidf_(v1.x), sigmoidf_(v1.y), sigmoidf_(v1.z), sigmoidf_(v1.w)};
                    }
                    u32x4 w; w.x = cvt_pk_bf16(v0.x, v0.y); w.y = cvt_pk_bf16(v0.z, v0.w); w.z = cvt_pk_bf16(v1.x, v1.y); w.w = cvt_pk_bf16(v1.z, v1.w);
                    *(u32x4*)(rowp + bj * HALF) = w;
                }
            }
    }
};
struct EpiBranch {
    static constexpr bool PERM = true;
    const bf16_t *GA, *GB; bf16_t* MG;
    __device__ __forceinline__ bool keep(const Unit& u) const { return u.aux == 0; }
    __device__ __forceinline__ void operator()(Acc& acc, const Unit& u, int wr, int wc, int fr, int fq) const {
        const int col0 = u.pn * BM + wc * 32 + 8 * fq;
#pragma unroll
        for (int ai = 0; ai < 2; ++ai)
#pragma unroll
            for (int m = 0; m < 4; ++m) {
                const int row = u.pm * BM + ai * HALF + wr * 64 + m * 16 + fr; const size_t off = (size_t)row * DM + col0;
#pragma unroll
                for (int bj = 0; bj < 2; ++bj) {
                    const u32x4 gb = *(const u32x4*)(GB + off + bj * HALF);
                    float b[8] = {bf16lo(gb.x), bf16hi(gb.x), bf16lo(gb.y), bf16hi(gb.y), bf16lo(gb.z), bf16hi(gb.z), bf16lo(gb.w), bf16hi(gb.w)};
#pragma unroll
                    for (int e = 0; e < 8; ++e) b[e] = fmaxf(b[e], 1e-30f);
                    if (u.aux == 0) {
                        const u32x4 ga = *(const u32x4*)(GA + off + bj * HALF);
                        const float a[8] = {bf16lo(ga.x), bf16hi(ga.x), bf16lo(ga.y), bf16hi(ga.y), bf16lo(ga.z), bf16hi(ga.z), bf16lo(ga.w), bf16hi(ga.w)};
#pragma unroll
                        for (int e = 0; e < 8; ++e) acc[ai][bj][m][e >> 2][e & 3] *= a[e] / b[e];
                    } else {
                        float v[8];
#pragma unroll
                        for (int e = 0; e < 8; ++e) v[e] = acc[ai][bj][m][e >> 2][e & 3] * b[e];
                        u32x4 w; w.x = cvt_pk_bf16(v[0], v[1]); w.y = cvt_pk_bf16(v[2], v[3]); w.z = cvt_pk_bf16(v[4], v[5]); w.w = cvt_pk_bf16(v[6], v[7]);
                        *(u32x4*)(MG + off + bj * HALF) = w;
                    }
                }
            }
    }
};

template <class Epi, class Sched>
__device__ __forceinline__ void gemm_phase(LAS unsigned char* lds, const Gemm g, const Sched& S, const Epi& E) {
    const int tid = threadIdx.x, wid = __builtin_amdgcn_readfirstlane(tid >> 6), lane = tid & 63, wr = wid >> 2, wc = wid & 3, fr = lane & 15, fq = lane >> 4;
    const int K = g.K, nt = K / BK;
    unsigned voffA[2], voffB[2];
#pragma unroll
    for (int i = 0; i < 2; ++i) { int R, C; stage_rc(tid * 16 + i * 8192, R, C); const int Rb = Epi::PERM ? ((R & ~31) + perm32(R & 31)) : R;
        voffA[i] = (unsigned)(R * g.lda + C) * 2u; voffB[i] = (unsigned)(Rb * g.ldb + C) * 2u; }
    const size_t kstep = (size_t)(BK * 2);
    const size_t hstepA = (size_t)HALF * g.lda * 2, hstepB = (size_t)HALF * g.ldb * 2;
    const unsigned ldsw = (unsigned)wid * 1024u;
    const int aoff = lds_byte(wr * 64 + fr, fq * 8), boff = lds_byte(wc * 32 + fr, fq * 8);
#define PG8_SA(b, h) (((b) * 2 + (h)) * HTB)
#define PG8_SB(b, h) ((4 + (b) * 2 + (h)) * HTB)
#define PG8_STAGE(bufoff, gbase, voff) do { _Pragma("unroll") for (int _i = 0; _i < 2; ++_i) \
        __builtin_amdgcn_global_load_lds((const unsigned*)((const char*)(gbase) + (voff)[_i]), (LAS unsigned*)(lds + (bufoff) + ldsw + _i * 8192), 16, 0, 0); } while (0)
#define PG8_LDA(dst, b, h) do { _Pragma("unroll") for (int m = 0; m < 4; ++m) _Pragma("unroll") for (int k = 0; k < 2; ++k) dst[m][k] = *(const LAS bf16x8*)(lds + PG8_SA(b, h) + aoff + m * 2048 + k * 1024); } while (0)
#define PG8_LDB(dst, b, h) do { _Pragma("unroll") for (int n = 0; n < 2; ++n) _Pragma("unroll") for (int k = 0; k < 2; ++k) dst[n][k] = *(const LAS bf16x8*)(lds + PG8_SB(b, h) + boff + n * 2048 + k * 1024); } while (0)
#define PG8_MMA(ai, bj, At, Bt) do { __builtin_amdgcn_s_setprio(1); _Pragma("unroll") for (int m = 0; m < 4; ++m) _Pragma("unroll") for (int n = 0; n < 2; ++n) _Pragma("unroll") for (int k = 0; k < 2; ++k) \
        acc[ai][bj][m][n] = __builtin_amdgcn_mfma_f32_16x16x32_bf16(Bt[n][k], At[m][k], acc[ai][bj][m][n], 0, 0, 0); __builtin_amdgcn_s_setprio(0); } while (0)
#define PG8_WAIT_V(n) asm volatile("s_waitcnt vmcnt(" #n ")" ::: "memory")
#define PG8_WAIT_L(n) asm volatile("s_waitcnt lgkmcnt(" #n ")" ::: "memory")
#define PG8_BAR __builtin_amdgcn_s_barrier()
#define PG8_SCHED __builtin_amdgcn_sched_barrier(0)
    Unit cur, nxt; int ui = 0;
    if (!S.next(0, cur)) return;
    Acc acc;
#pragma unroll
    for (int a = 0; a < 2; ++a)
#pragma unroll
        for (int b = 0; b < 2; ++b)
#pragma unroll
            for (int m = 0; m < 4; ++m)
#pragma unroll
                for (int n = 0; n < 2; ++n) acc[a][b][m][n] = (f32x4){0.f, 0.f, 0.f, 0.f};
    bf16x8 At[4][2], B0[2][2], B1[2][2];
    const char* cA = S.aptr(cur); const char* cB = S.bptr(cur);
    PG8_STAGE(PG8_SB(0, 0), cB, voffB); PG8_STAGE(PG8_SB(0, 1), cB + hstepB, voffB); PG8_STAGE(PG8_SA(0, 0), cA, voffA); PG8_STAGE(PG8_SA(0, 1), cA + hstepA, voffA);
    if (wr == 1) PG8_BAR;
    PG8_WAIT_V(2); PG8_BAR;
    PG8_STAGE(PG8_SB(1, 0), cB + kstep, voffB); PG8_STAGE(PG8_SA(1, 0), cA + kstep, voffA); PG8_STAGE(PG8_SB(1, 1), cB + hstepB + kstep, voffB);
    PG8_WAIT_V(6); PG8_BAR;
    for (;;) {
        const bool has_next = S.next(ui + 1, nxt);
        const char* nA = has_next ? S.aptr(nxt) : cA; const char* nB = has_next ? S.bptr(nxt) : cB;
        for (int t = 0; t < nt; t += 2) {
            const bool last = (t == nt - 2);
            const char* a1 = cA + (size_t)(t + 1) * kstep;
            const char* a2 = last ? nA : cA + (size_t)(t + 2) * kstep; const char* b2 = last ? nB : cB + (size_t)(t + 2) * kstep;
            const char* a3 = a2 + kstep; const char* b3 = b2 + kstep;
            PG8_LDB(B0, 0, 0); PG8_LDB(B1, 0, 1); PG8_SCHED; PG8_LDA(At, 0, 0); PG8_STAGE(PG8_SA(1, 1), a1 + hstepA, voffA);
            PG8_WAIT_V(8); PG8_WAIT_L(0); PG8_BAR; PG8_MMA(0, 0, At, B0); PG8_MMA(0, 1, At, B1); PG8_BAR; PG8_SCHED;
            PG8_LDA(At, 0, 1); PG8_STAGE(PG8_SB(0, 0), b2, voffB); PG8_STAGE(PG8_SB(0, 1), b2 + hstepB, voffB); PG8_STAGE(PG8_SA(0, 0), a2, voffA);
            PG8_WAIT_V(8); PG8_WAIT_L(0); PG8_BAR; PG8_MMA(1, 0, At, B0); PG8_MMA(1, 1, At, B1); PG8_BAR; PG8_SCHED;
            PG8_LDB(B0, 1, 0); PG8_LDB(B1, 1, 1); PG8_SCHED; PG8_LDA(At, 1, 0); PG8_STAGE(PG8_SA(0, 1), a2 + hstepA, voffA);
            PG8_WAIT_V(8); PG8_WAIT_L(0); PG8_BAR; PG8_MMA(0, 0, At, B0); PG8_MMA(0, 1, At, B1); PG8_BAR; PG8_SCHED;
            PG8_LDA(At, 1, 1); PG8_STAGE(PG8_SB(1, 0), b3, voffB); PG8_STAGE(PG8_SB(1, 1), b3 + hstepB, voffB); PG8_STAGE(PG8_SA(1, 0), a3, voffA);
            PG8_WAIT_V(8); PG8_WAIT_L(0); PG8_BAR; PG8_MMA(1, 0, At, B0); PG8_MMA(1, 1, At, B1); PG8_BAR; PG8_SCHED;
        }
        if (wr == 0) PG8_BAR;
        E(acc, cur, wr, wc, fr, fq);
        if (!has_next) break;
        if (!E.keep(cur)) {
#pragma unroll
            for (int a = 0; a < 2; ++a)
#pragma unroll
                for (int b = 0; b < 2; ++b)
#pragma unroll
                    for (int m = 0; m < 4; ++m)
#pragma unroll
                        for (int n = 0; n < 2; ++n) acc[a][b][m][n] = (f32x4){0.f, 0.f, 0.f, 0.f};
        }
        cur = nxt; cA = nA; cB = nB; ++ui;
        if (wr == 1) PG8_BAR;
    }
    PG8_WAIT_V(0);
    PG8_BAR;
#undef PG8_SA
#undef PG8_SB
#undef PG8_STAGE
#undef PG8_LDA
#undef PG8_LDB
#undef PG8_MMA
#undef PG8_WAIT_V
#undef PG8_WAIT_L
#undef PG8_BAR
#undef PG8_SCHED
}
}

namespace att {
constexpr int STG = 32768, L_TAB = 65536, L_WSF = L_TAB + 2048, L_END = L_WSF + 2048;
static_assert(L_END <= RING_BYTES, "attention LDS");
__device__ __forceinline__ int crow(int r, int hi) { return (r & 3) + 8 * (r >> 2) + 4 * hi; }
__device__ __forceinline__ s16x4 vtr(const LAS char* p) { return __builtin_bit_cast(s16x4, __builtin_amdgcn_ds_read_tr16_b64_v4i16((LAS s16x4*)p)); }
__device__ __forceinline__ int t5_bucket(int rel) {
    const int n = rel < 0 ? -rel : rel;
    const int large = 8 + (n >= 12) + (n >= 16) + (n >= 23) + (n >= 32) + (n >= 46) + (n >= 64) + (n >= 91);
    return (rel > 0 ? 16 : 0) + (n < 8 ? n : large);
}
struct Params {
    const bf16_t* QQ; const bf16_t *KA, *VA, *KB, *VB; bf16_t* Y;
    const float *relA, *t5, *lq1, *lk1, *lq2, *lk2, *subg;
};

template <int MODE>
__device__ __forceinline__ void unit(LAS char* lds, const Params& P, int b, int hp, int qb) {
    constexpr int NDB = MODE == 0 ? 2 : 4;
    const int tid = threadIdx.x, lane = tid & 63, r32 = lane & 31, hi = lane >> 5;
    const int w = __builtin_amdgcn_readfirstlane(tid >> 6), g = w >> 2, wq = w & 3;
    const bf16_t* Kslab = (MODE == 0 ? P.KA : P.KB) + (size_t)b * SEQ * 512 + hp * 128;
    const bf16_t* Vslab = (MODE == 0 ? P.VA : P.VB) + (size_t)b * SEQ * 512 + hp * 128;
    const int qcol = (MODE == 0 ? 0 : 512) + hp * 128;
    const int qrow0 = qb * 128 + wq * 32;
    const size_t grow0 = (size_t)b * SEQ + qrow0;
    const int cq = qrow0 >> 6;
    const int t_hi = 2 * qb + 1, t_lo = MODE == 0 ? (2 * qb - 8 > 0 ? 2 * qb - 8 : 0) : 0;
    const int w_lo = MODE == 0 ? cq - 8 : 0;
    LAS float* tab = (LAS float*)(lds + L_TAB);
    if (tid < 512) {
        const int gg = tid >> 8, idx = tid & 255, rel = idx - 191; float v;
        if (MODE == 0) { const float* tb = P.relA + (2 * hp + gg) * 257; const int rc = rel < -128 ? -128 : (rel > 128 ? 128 : rel); v = (tb[rc + 128] - tb[0]) * LOG2E; }
        else { const float* tb = P.t5 + hp * 32; v = (tb[t5_bucket(rel)] - tb[15]) * LOG2E; }
        tab[gg * 256 + idx] = v;
    }
    bf16x8 qf[4];
#pragma unroll
    for (int s = 0; s < 4; ++s) qf[s] = *(const bf16x8*)(P.QQ + (grow0 + r32) * 1024 + qcol + 64 * g + 16 * s + 8 * hi);
    const bf16_t* ksrc = Kslab + (size_t)lane * 512 + w * 8;
    const bf16_t* vsrc = Vslab + (size_t)(16 * (w & 3) + (lane >> 2)) * 512 + (w >> 2) * 32 + (lane & 3) * 8;
#define ATT_STAGE(t, boff) do { const size_t ro_ = (size_t)(t) * 64 * 512; \
        __builtin_amdgcn_global_load_lds((const unsigned*)(ksrc + ro_), (LAS unsigned*)(lds + (boff) + w * 1024), 16, 0, 0); \
        __builtin_amdgcn_global_load_lds((const unsigned*)(ksrc + ro_ + 64), (LAS unsigned*)(lds + (boff) + (w + 8) * 1024), 16, 0, 0); \
        __builtin_amdgcn_global_load_lds((const unsigned*)(vsrc + ro_), (LAS unsigned*)(lds + (boff) + 16384 + w * 1024), 16, 0, 0); \
        __builtin_amdgcn_global_load_lds((const unsigned*)(vsrc + ro_ + 64), (LAS unsigned*)(lds + (boff) + 16384 + (w + 8) * 1024), 16, 0, 0); } while (0)
    ATT_STAGE(t_lo, (t_lo & 1) * STG);
    f32x16 o[NDB];
#pragma unroll
    for (int d = 0; d < NDB; ++d) o[d] = (f32x16){};
    float mrun = -1e30f, lrun = 0.f;
    LAS float* wsf = (LAS float*)(lds + L_WSF) + w * 64;
    const int koff = (8 * g + hi) * 1024 + r32 * 16;
    const int voff = 16384 + (MODE == 0 ? 2 * g * 4096 : 0) + ((lane >> 4) & 1) * 32 + (lane & 3) * 8 + (4 * hi + ((lane & 15) >> 2)) * 64;
    asm volatile("s_waitcnt vmcnt(0)" ::: "memory"); __syncthreads();
    for (int t = t_lo; t <= t_hi; ++t) {
        const int boff = (t & 1) * STG;
        if (t < t_hi) ATT_STAGE(t + 1, ((t + 1) & 1) * STG);
        if (t >= w_lo && t <= cq) {
            const LAS char* kb = lds + boff + koff;
            f32x16 s0 = (f32x16){}, s1 = (f32x16){};
#pragma unroll
            for (int s = 0; s < 4; ++s) {
                const bf16x8 k0 = *(const LAS bf16x8*)(kb + s * 2048), k1 = *(const LAS bf16x8*)(kb + s * 2048 + 512);
                s0 = __builtin_amdgcn_mfma_f32_32x32x16_bf16(k0, qf[s], s0, 0, 0, 0); s1 = __builtin_amdgcn_mfma_f32_32x32x16_bf16(k1, qf[s], s1, 0, 0, 0);
            }
            if (t >= cq - 2) {
                const LAS float* tb = tab + (MODE == 0 ? g * 256 : 0) + (64 * t - (qrow0 + r32) + 191 + 4 * hi);
#pragma unroll
                for (int r = 0; r < 16; ++r) { s0[r] += tb[(r & 3) + 8 * (r >> 2)]; s1[r] += tb[32 + (r & 3) + 8 * (r >> 2)]; }
            }
            float rm = fmaxf(s0[0], s1[0]);
#pragma unroll
            for (int r = 1; r < 16; ++r) rm = fmaxf(rm, fmaxf(s0[r], s1[r]));
            rm = fmaxf(rm, __shfl_xor(rm, 32));
            if (__any(rm > mrun + 8.0f)) {
                const float mn = fmaxf(mrun, rm), al = fast_exp2(mrun - mn);
                lrun *= al; mrun = mn;
                if (hi == 0) wsf[r32] = al;
                __builtin_amdgcn_wave_barrier();
#pragma unroll
                for (int r = 0; r < 16; ++r) { const float f = wsf[crow(r, hi)];
#pragma unroll
                    for (int d = 0; d < NDB; ++d) o[d][r] *= f; }
                __builtin_amdgcn_wave_barrier();
            }
            float ls = 0.f;
#pragma unroll
            for (int r = 0; r < 16; ++r) { s0[r] = fast_exp2(s0[r] - mrun); s1[r] = fast_exp2(s1[r] - mrun); ls += s0[r] + s1[r]; }
            lrun += ls;
            bf16x8 pa[4];
            { u32x4 t0, t1, t2, t3;
              t0.x = cvt_pk_bf16(s0[0], s0[1]); t0.y = cvt_pk_bf16(s0[2], s0[3]); t0.z = cvt_pk_bf16(s0[4], s0[5]); t0.w = cvt_pk_bf16(s0[6], s0[7]);
              t1.x = cvt_pk_bf16(s0[8], s0[9]); t1.y = cvt_pk_bf16(s0[10], s0[11]); t1.z = cvt_pk_bf16(s0[12], s0[13]); t1.w = cvt_pk_bf16(s0[14], s0[15]);
              t2.x = cvt_pk_bf16(s1[0], s1[1]); t2.y = cvt_pk_bf16(s1[2], s1[3]); t2.z = cvt_pk_bf16(s1[4], s1[5]); t2.w = cvt_pk_bf16(s1[6], s1[7]);
              t3.x = cvt_pk_bf16(s1[8], s1[9]); t3.y = cvt_pk_bf16(s1[10], s1[11]); t3.z = cvt_pk_bf16(s1[12], s1[13]); t3.w = cvt_pk_bf16(s1[14], s1[15]);
              pa[0] = __builtin_bit_cast(bf16x8, t0); pa[1] = __builtin_bit_cast(bf16x8, t1); pa[2] = __builtin_bit_cast(bf16x8, t2); pa[3] = __builtin_bit_cast(bf16x8, t3); }
            const LAS char* vb = lds + boff + voff;
#pragma unroll
            for (int d = 0; d < NDB; ++d)
#pragma unroll
                for (int ks = 0; ks < 4; ++ks) {
                    const s16x4 lo = vtr(vb + d * 4096 + ks * 1024), hh = vtr(vb + d * 4096 + ks * 1024 + 512);
                    const bf16x8 vf = {lo[0], lo[1], lo[2], lo[3], hh[0], hh[1], hh[2], hh[3]};
                    o[d] = __builtin_amdgcn_mfma_f32_32x32x16_bf16(pa[ks], vf, o[d], 0, 0, 0);
                }
        }
        asm volatile("s_waitcnt vmcnt(0)" ::: "memory"); __syncthreads();
    }
#undef ATT_STAGE
    const float lt = lrun + __shfl_xor(lrun, 32);
    if (hi == 0) wsf[32 + r32] = fast_rcp(lt);
    __builtin_amdgcn_wave_barrier();
    float inv[16];
#pragma unroll
    for (int r = 0; r < 16; ++r) inv[r] = wsf[32 + crow(r, hi)];
    if (MODE == 0) {
        bf16_t* yo = P.Y + grow0 * 1024 + qcol + 64 * g + r32;
#pragma unroll
        for (int r = 0; r < 16; ++r)
#pragma unroll
            for (int d = 0; d < NDB; ++d) yo[(size_t)crow(r, hi) * 1024 + 32 * d] = (bf16_t)(cvt_pk_bf16(o[d][r] * inv[r], 0.f) & 0xffffu);
        __syncthreads();
    } else {
        const float s1 = wave_sum(P.lq1[lane] * P.lk1[lane]), s2 = wave_sum(P.lq2[lane] * P.lk2[lane]);
        const float lam = __expf(s1) - __expf(s2) + 0.2f;
        LAS float* X = (LAS float*)lds;
        if (g == 1) {
#pragma unroll
            for (int r = 0; r < 16; ++r)
#pragma unroll
                for (int d = 0; d < 4; ++d) X[((wq * 16 + r) * 4 + d) * 64 + lane] = o[d][r] * inv[r] * lam;
        }
        __syncthreads();
        if (g == 0) {
            float sg[4];
#pragma unroll
            for (int d = 0; d < 4; ++d) sg[d] = P.subg[32 * d + r32] * 0.8f;
            bf16_t* yo = P.Y + grow0 * 1024 + qcol + r32;
#pragma unroll
            for (int r = 0; r < 16; ++r) {
                float dv[4]; float ss = 0.f;
#pragma unroll
                for (int d = 0; d < 4; ++d) { dv[d] = o[d][r] * inv[r] - X[((wq * 16 + r) * 4 + d) * 64 + lane]; ss += dv[d] * dv[d]; }
                ss += __shfl_xor(ss, 1); ss += __shfl_xor(ss, 2); ss += __shfl_xor(ss, 4); ss += __shfl_xor(ss, 8); ss += __shfl_xor(ss, 16);
                const float rn = __builtin_amdgcn_rsqf(ss * (1.0f / 128.0f) + EPS);
#pragma unroll
                for (int d = 0; d < 4; ++d) yo[(size_t)crow(r, hi) * 1024 + 32 * d] = (bf16_t)(cvt_pk_bf16(dv[d] * rn * sg[d], 0.f) & 0xffffu);
            }
        }
        __syncthreads();
    }
}
}

typedef GAS unsigned gu32;
#define XB_TMO      128
#define XB_XCNT(j)  (256  + 64 * (j))
#define XB_XSUB(j)  (1280 + 64 * (j))
#define XB_XGEN(j)  (2304 + 64 * (j))
#define XB_TOP      3328
#define XB_TOPGEN   3392
#define XCD_BAR_WORDS 3456
#define XB_SPIN_CAP (1u << 18)
__device__ __forceinline__ unsigned xb_ld(unsigned* p)              { return __hip_atomic_load(p, __ATOMIC_RELAXED, __HIP_MEMORY_SCOPE_AGENT); }
__device__ __forceinline__ unsigned xb_add(unsigned* p, unsigned v) { return __hip_atomic_fetch_add(p, v, __ATOMIC_RELAXED, __HIP_MEMORY_SCOPE_AGENT); }
__device__ __forceinline__ unsigned xb_xcc_id() { return (unsigned)__builtin_amdgcn_s_getreg((3 << 11) | 20) & 0xFu; }
#define XB_SPIN(cond, bar) do { unsigned _sp = 0; while (cond) { __builtin_amdgcn_s_sleep(1); \
    if ((++_sp & 255u) == 0u) { if (xb_ld(&(bar)[XB_TMO])) break; if (_sp > XB_SPIN_CAP) { atomicAdd(&(bar)[XB_TMO], 1u); break; } } } } while (0)
struct XcdBarrier { unsigned* bar; unsigned x; volatile LAS unsigned* st; };
__device__ __forceinline__ XcdBarrier xcd_barrier_post(unsigned* bar, volatile LAS unsigned* st) {
    XcdBarrier b; b.bar = bar; b.x = xb_xcc_id(); b.st = st;
    if (threadIdx.x == 0) (void)xb_add(&bar[XB_XCNT(b.x)], 1u);
    return b;
}
__device__ __forceinline__ void xcd_barrier_complete(unsigned* bar, unsigned x, unsigned& nloc, unsigned& nx) {
    const unsigned G = gridDim.x * gridDim.y * gridDim.z;
    unsigned sum, cnt, mine, sp = 0u;
    for (;;) {
        sum = 0u; cnt = 0u; mine = 0u;
#pragma unroll
        for (unsigned j = 0; j < 16; ++j) { const unsigned c = xb_ld(&bar[XB_XCNT(j)]); sum += c; cnt += (c > 0u) ? 1u : 0u; mine = (j == x) ? c : mine; }
        if (sum == G) break;
        __builtin_amdgcn_s_sleep(1);
        if ((++sp & 255u) == 0u) { if (xb_ld(&bar[XB_TMO])) break; if (sp > XB_SPIN_CAP) { atomicAdd(&bar[XB_TMO], 1u); break; } }
    }
    nloc = mine > 0u ? mine : 1u; nx = cnt > 0u ? cnt : 1u;
}
__device__ __forceinline__ void xcd_barrier(const XcdBarrier& b) {
    asm volatile("s_waitcnt vmcnt(0)" ::: "memory");
    __syncthreads();
    if (threadIdx.x == 0) {
        unsigned* bar = b.bar;
        __builtin_amdgcn_s_waitcnt(0);
        unsigned nloc = b.st[0], nx = b.st[1];
        if (nloc == 0u) { xcd_barrier_complete(bar, b.x, nloc, nx); b.st[0] = nloc; b.st[1] = nx; }
        const unsigned old = xb_add(&bar[XB_XSUB(b.x)], 1u);
        const unsigned gen = old / nloc;
        if (old + 1u == (gen + 1u) * nloc) {
            __builtin_amdgcn_fence(__ATOMIC_RELEASE, "agent");
            asm volatile("s_waitcnt vmcnt(0)" ::: "memory");
            const unsigned og = xb_add(&bar[XB_TOP], 1u);
            const unsigned tg = og / nx;
            if (og + 1u == (tg + 1u) * nx) xb_add(&bar[XB_TOPGEN], 1u);
            else XB_SPIN(xb_ld(&bar[XB_TOPGEN]) == tg, bar);
            __builtin_amdgcn_fence(__ATOMIC_ACQUIRE, "agent");
            xb_add(&bar[XB_XGEN(b.x)], 1u);
            asm volatile("s_waitcnt vmcnt(0)" ::: "memory");
        } else {
            XB_SPIN(xb_ld(&bar[XB_XGEN(b.x)]) == gen, bar);
            __builtin_amdgcn_fence(__ATOMIC_ACQUIRE, "agent");
            asm volatile("s_waitcnt vmcnt(0)" ::: "memory");
        }
    }
    __syncthreads();
}

__device__ __forceinline__ unsigned f2bf(float f) { unsigned u = __builtin_bit_cast(unsigned, f); return (u + 0x7fffu + ((u >> 16) & 1u)) >> 16; }
__device__ __forceinline__ unsigned pk2(float lo, float hi) { return f2bf(lo) | (f2bf(hi) << 16); }
template <bool SWI, bool GAIN>
__device__ __forceinline__ void p0_transpose_item(const float* W, int K, int N, const float* gain, bf16_t* WT, LAS float* scr, int item, int lane) {
    const int nblk = N / 32, kb = item / nblk, nb = item % nblk, k0 = 64 * kb, n0 = 32 * nb;
#pragma unroll 8
    for (int i = 0; i < 32; ++i) { const int kk = 2 * i + (lane >> 5); const float gk = GAIN ? gain[k0 + kk] : 1.0f; scr[kk * 33 + (lane & 31)] = W[(size_t)(k0 + kk) * N + n0 + (lane & 31)] * gk; }
    asm volatile("s_waitcnt lgkmcnt(0)" ::: "memory");
    int r0 = n0;
    if (SWI) { const int half = n0 >= DFF, nn = n0 - half * DFF; r0 = (nn >> 7) * 256 + half * 128 + (nn & 127); }
    const int c = lane & 7;
#pragma unroll
    for (int j = 0; j < 4; ++j) { const int n = (lane >> 3) + 8 * j; const LAS float* s = scr + (8 * c) * 33 + n;
        u32x4 o; o.x = pk2(s[0 * 33], s[1 * 33]); o.y = pk2(s[2 * 33], s[3 * 33]); o.z = pk2(s[4 * 33], s[5 * 33]); o.w = pk2(s[6 * 33], s[7 * 33]);
        *(GAS u32x4*)(WT + (size_t)(r0 + n) * K + k0 + 8 * c) = o; }
    asm volatile("s_waitcnt lgkmcnt(0)" ::: "memory");
}

constexpr int N_PHASES = 10;
struct Args { const float* in[21]; float* out; unsigned char* ws; int ph_lo, ph_hi; };
static_assert(sizeof(Args) == 21 * 8 + 8 + 8 + 8, "Args has no padding");

__global__ void __launch_bounds__(NWAVES * 64, 2) fwd_kernel(Args args) {
    extern __shared__ __attribute__((aligned(16))) unsigned char lds_raw[];
    LAS unsigned char* lds = (LAS unsigned char*)lds_raw;
    volatile LAS unsigned* MISC = (volatile LAS unsigned*)(lds + MISC_OFF);
    const int tid = threadIdx.x, lane = tid & 63, wave = __builtin_amdgcn_readfirstlane(tid >> 6);
    const int G = gridDim.x, bx = blockIdx.x;
    const int vcu = (G % 8 == 0) ? (bx % 8) * (G / 8) + bx / 8 : bx;
    unsigned char* ws = args.ws;
    const float* x = args.in[0]; const float* g_ffn1 = args.in[1]; const float* w_in1 = args.in[2]; const float* w_out1 = args.in[3];
    const float* g_mix = args.in[4]; const float* w_mix = args.in[5]; const float* b_gate = args.in[6]; const float* rel_a = args.in[7];
    const float* lq1 = args.in[8]; const float* lk1 = args.in[9]; const float* lq2 = args.in[10]; const float* lk2 = args.in[11];
    const float* subg = args.in[12]; const float* t5 = args.in[13]; const float* w_a = args.in[14]; const float* w_b = args.in[15];
    const float* w_o = args.in[16]; const float* g_ffn2 = args.in[17]; const float* w_in2 = args.in[18]; const float* w_out2 = args.in[19]; const float* g_fin = args.in[20];
    float* out = args.out;
    float* SSQ0 = (float*)(ws + WS_SSQ0); float* SSQ1 = (float*)(ws + WS_SSQ1); float* SSQ2 = (float*)(ws + WS_SSQ2); float* SSQ3 = (float*)(ws + WS_SSQ3);
    bf16_t* WIN1 = (bf16_t*)(ws + WS_WIN1); bf16_t* WOUT1 = (bf16_t*)(ws + WS_WOUT1); bf16_t* WMIX = (bf16_t*)(ws + WS_WMIX); bf16_t* WA = (bf16_t*)(ws + WS_WA);
    bf16_t* WB = (bf16_t*)(ws + WS_WB); bf16_t* WO = (bf16_t*)(ws + WS_WO); bf16_t* WIN2 = (bf16_t*)(ws + WS_WIN2); bf16_t* WOUT2 = (bf16_t*)(ws + WS_WOUT2);
    bf16_t* XB = (bf16_t*)(ws + WS_XB); bf16_t* HB = (bf16_t*)(ws + WS_H);
    bf16_t* QQ = (bf16_t*)(ws + WS_QQ); bf16_t* KA = (bf16_t*)(ws + WS_KA); bf16_t* VA = (bf16_t*)(ws + WS_VA); bf16_t* KB = (bf16_t*)(ws + WS_KB); bf16_t* VB = (bf16_t*)(ws + WS_VB);
    bf16_t* GA = (bf16_t*)(ws + WS_GA); bf16_t* GB = (bf16_t*)(ws + WS_GB); bf16_t* MG = (bf16_t*)(ws + WS_MG);

    for (int u = tid; u < (LDS_BYTES - LDSCTL_OFF) / 4; u += NWAVES * 64) ((LAS unsigned*)(lds + LDSCTL_OFF))[u] = 0u;
    __syncthreads();
    const int lo = args.ph_lo, hi = args.ph_hi;
    const bool one_launch = (hi - lo) > 1;
    XcdBarrier bar; bar.bar = (unsigned*)(ws + WS_CTL) + CW_BAR; bar.x = 0; bar.st = nullptr;
    if (one_launch) bar = xcd_barrier_post((unsigned*)(ws + WS_CTL) + CW_BAR, MISC + 8);
#define IN(k) (lo <= (k) && (k) < hi)
#define SEAM(k) do { if (IN(k) && IN((k) + 1)) { if ((k) == 0) { cg::this_grid().sync(); } else { xcd_barrier(bar); } } } while (0)

    if (IN(0)) {
        LAS float* scr = (LAS float*)(lds + wave * 16384);
        const int gw = vcu * NWAVES + wave, NGW = G * NWAVES;
        constexpr int I_IN = (DM / 64) * (NFF / 32), I_OUT = (DFF / 64) * (DM / 32), I_MIX = (DM / 64) * (NMIX / 32), I_BR = (512 / 64) * (DM / 32), I_O = (DM / 64) * (DM / 32);
        constexpr int NITEMS = 2 * I_IN + 2 * I_OUT + I_MIX + 2 * I_BR + I_O;
        for (int it = gw; it < NITEMS; it += NGW) {
            int r = it;
            if (r < I_IN) { p0_transpose_item<true, true>(w_in1, DM, NFF, g_ffn1, WIN1, scr, r, lane); continue; } r -= I_IN;
            if (r < I_IN) { p0_transpose_item<true, true>(w_in2, DM, NFF, g_ffn2, WIN2, scr, r, lane); continue; } r -= I_IN;
            if (r < I_OUT) { p0_transpose_item<false, false>(w_out1, DFF, DM, nullptr, WOUT1, scr, r, lane); continue; } r -= I_OUT;
            if (r < I_OUT) { p0_transpose_item<false, false>(w_out2, DFF, DM, nullptr, WOUT2, scr, r, lane); continue; } r -= I_OUT;
            if (r < I_MIX) { p0_transpose_item<false, true>(w_mix, DM, NMIX, g_mix, WMIX, scr, r, lane); continue; } r -= I_MIX;
            if (r < I_BR) { p0_transpose_item<false, false>(w_a, 512, DM, nullptr, WA, scr, r, lane); continue; } r -= I_BR;
            if (r < I_BR) { p0_transpose_item<false, false>(w_b, 512, DM, nullptr, WB, scr, r, lane); continue; } r -= I_BR;
            p0_transpose_item<false, false>(w_o, DM, DM, nullptr, WO, scr, r, lane);
        }
        for (int m = gw; m < M; m += NGW) {
            const GAS f32x4* xr = (const GAS f32x4*)(x + (size_t)m * DM) + lane;
            f32x4 v[4]; float s = 0.f;
#pragma unroll
            for (int j = 0; j < 4; ++j) { v[j] = xr[64 * j]; s += (v[j].x * v[j].x + v[j].y * v[j].y) + (v[j].z * v[j].z + v[j].w * v[j].w); }
            s = wave_sum(s);
            GAS u32x2* o8 = (GAS u32x2*)(XB + (size_t)m * DM) + lane;
#pragma unroll
            for (int j = 0; j < 4; ++j) { u32x2 wv; wv.x = cvt_pk_bf16(v[j].x, v[j].y); wv.y = cvt_pk_bf16(v[j].z, v[j].w); o8[64 * j] = wv; }
            if (lane < 16) SSQ0[(size_t)m * 16 + lane] = lane == 0 ? s : 0.f;
        }
    }
    SEAM(0);
    if (IN(1)) {
        pg8::Gemm g{DM, DM, DM}; pg8::StaticOrder S{XB, WIN1, DM, DM, M / 256, NFF / 256, G, bx};
        pg8::EpiSwiglu E{HB, SSQ0};
        pg8::gemm_phase(lds, g, S, E);
    }
    SEAM(1);
    if (IN(2)) {
        pg8::Gemm g{DFF, DFF, DFF}; pg8::StaticOrder S{HB, WOUT1, DFF, DFF, M / 256, DM / 256, G, bx};
        pg8::EpiResid E{x, out, XB, SSQ1, 0.5f};
        pg8::gemm_phase(lds, g, S, E);
    }
    SEAM(2);
    if (IN(3)) {
        pg8::Gemm g{DM, DM, DM}; pg8::StaticOrder S{XB, WMIX, DM, DM, M / 256, NMIX / 256, G, bx};
        pg8::EpiMix E{QQ, KA, VA, KB, VB, GA, GB, SSQ1, b_gate};
        pg8::gemm_phase(lds, g, S, E);
    }
    SEAM(3);
    if (IN(4)) {
        att::Params P{QQ, KA, VA, KB, VB, QQ, rel_a, t5, lq1, lk1, lq2, lk2, subg};
        for (int v = vcu; v < 256; v += G) {
            const int bh = v >> 3, j = v & 7, b = bh >> 2, hp = bh & 3;
            att::unit<1>((LAS char*)lds, P, b, hp, 15 - j);
            att::unit<0>((LAS char*)lds, P, b, hp, 15 - j);
            att::unit<1>((LAS char*)lds, P, b, hp, j);
            att::unit<0>((LAS char*)lds, P, b, hp, j);
        }
    }
    SEAM(4);
    if (IN(5)) {
        pg8::Gemm g{DM, 512, 512}; pg8::BranchOrder S{QQ, QQ + 512, WA, WB, DM, 512, M / 256, DM / 256, G, bx};
        pg8::EpiBranch E{GA, GB, MG};
        pg8::gemm_phase(lds, g, S, E);
    }
    SEAM(5);
    if (IN(6)) {
        pg8::Gemm g{DM, DM, DM}; pg8::StaticOrder S{MG, WO, DM, DM, M / 256, DM / 256, G, bx};
        pg8::EpiResid E{out, out, XB, SSQ2, 1.0f};
        pg8::gemm_phase(lds, g, S, E);
    }
    SEAM(6);
    if (IN(7)) {
        pg8::Gemm g{DM, DM, DM}; pg8::StaticOrder S{XB, WIN2, DM, DM, M / 256, NFF / 256, G, bx};
        pg8::EpiSwiglu E{HB, SSQ2};
        pg8::gemm_phase(lds, g, S, E);
    }
    SEAM(7);
    if (IN(8)) {
        pg8::Gemm g{DFF, DFF, DFF}; pg8::StaticOrder S{HB, WOUT2, DFF, DFF, M / 256, DM / 256, G, bx};
        pg8::EpiResid E{out, out, nullptr, SSQ3, 0.5f};
        pg8::gemm_phase(lds, g, S, E);
    }
    SEAM(8);
    if (IN(9)) {
        const int gw = vcu * NWAVES + wave, NGW = G * NWAVES;
        f32x4 gv[4];
#pragma unroll
        for (int j = 0; j < 4; ++j) gv[j] = ((const f32x4*)g_fin)[lane + 64 * j];
        for (int m = gw; m < M; m += NGW) {
            const float rs = row_rstd(SSQ3, m);
            f32x4* xr = (f32x4*)(out + (size_t)m * DM) + lane;
#pragma unroll
            for (int j = 0; j < 4; ++j) { const f32x4 v = xr[64 * j]; xr[64 * j] = v * rs * gv[j]; }
        }
    }
#undef IN
#undef SEAM
}

extern "C" void kernel_launch(void* const* d_in, const int* in_sizes, int n_in, void* d_out, int out_size, void* d_ws, size_t ws_size, hipStream_t stream) {
    static int grid = 0;
    if (grid == 0) {
        if (n_in != 21 || in_sizes[0] != M * DM || out_size != M * DM || ws_size < WS_END) { fprintf(stderr, "kernel_launch: unexpected shapes (n_in %d, in0 %d, out %d, ws %zu); nothing launched\n", n_in, n_in > 0 ? in_sizes[0] : -1, out_size, ws_size); grid = -1; return; }
        int dev = 0, cus = 0, per_cu = 0;
        if (hipGetDevice(&dev) != hipSuccess || hipDeviceGetAttribute(&cus, hipDeviceAttributeMultiprocessorCount, dev) != hipSuccess) { fprintf(stderr, "kernel_launch: device query failed\n"); grid = -1; return; }
        if (hipFuncSetAttribute((const void*)fwd_kernel, hipFuncAttributeMaxDynamicSharedMemorySize, LDS_BYTES) != hipSuccess) { fprintf(stderr, "kernel_launch: hipFuncSetAttribute failed\n"); grid = -1; return; }
        if (hipOccupancyMaxActiveBlocksPerMultiprocessor(&per_cu, (const void*)fwd_kernel, NWAVES * 64, LDS_BYTES) != hipSuccess || per_cu < 1) { fprintf(stderr, "kernel_launch: occupancy query says %d blocks per CU\n", per_cu); per_cu = 1; }
        (void)hipGetLastError();
        grid = cus;
    }
    if (grid < 0) return;
    if (hipMemsetAsync((char*)d_ws + WS_CTL, 0, CTL_ZERO_BYTES, stream) != hipSuccess) { fprintf(stderr, "kernel_launch: hipMemsetAsync failed\n"); return; }
    Args a{};
    for (int i = 0; i < 21; ++i) a.in[i] = (const float*)d_in[i];
    a.out = (float*)d_out; a.ws = (unsigned char*)d_ws;
#if MK_N_LAUNCHES == 1
    a.ph_lo = 0; a.ph_hi = N_PHASES;
    void* kargs[] = {&a};
    hipError_t e = hipLaunchCooperativeKernel((const void*)fwd_kernel, dim3(grid), dim3(NWAVES * 64), kargs, LDS_BYTES, stream);
    if (e != hipSuccess) fprintf(stderr, "kernel_launch: cooperative launch failed: %s (grid %d)\n", hipGetErrorString(e), grid);
#else
    for (int p = 0; p < N_PHASES; ++p) {
        a.ph_lo = p; a.ph_hi = p + 1;
        hipLaunchKernelGGL(fwd_kernel, dim3(grid), dim3(NWAVES * 64), LDS_BYTES, stream, a);
    }
#endif
}
```

```cpp
#include <hip/hip_runtime.h>
#include <hip/hip_cooperative_groups.h>
#include <cstdio>
#include <cstdint>
namespace cg = cooperative_groups;

#ifndef MK_N_LAUNCHES
#define MK_N_LAUNCHES 1
#endif

#ifndef PROBE_DUP
#define PROBE_DUP -1
#endif
#define LAS __attribute__((address_space(3)))
#define GAS __attribute__((address_space(1)))
typedef unsigned short bf16_t;
typedef short bf16x8 __attribute__((ext_vector_type(8)));
typedef short s16x4 __attribute__((ext_vector_type(4)));
typedef float f32x4 __attribute__((ext_vector_type(4)));
typedef float f32x16 __attribute__((ext_vector_type(16)));
typedef float f32x2 __attribute__((ext_vector_type(2)));
typedef unsigned u32x4 __attribute__((ext_vector_type(4)));
typedef unsigned u32x2 __attribute__((ext_vector_type(2)));
typedef __bf16 bf16x2_t __attribute__((ext_vector_type(2)));

constexpr int BATCH = 8, SEQ = 2048, DM = 1024, M = BATCH * SEQ;
constexpr int DFF = 2816, NFF = 2 * DFF, NMIX = 5120;
constexpr float EPS = 1e-6f;
constexpr float LOG2E = 1.4426950408889634f;
constexpr float QSCALE = 0.125f * LOG2E;
constexpr int NWAVES = 8;

constexpr size_t MiB = 1u << 20;
constexpr size_t WS_CTL = 0, CTL_ZERO_BYTES = 64 * 1024;
constexpr size_t WS_SSQ0 = 1 * MiB, WS_SSQ1 = 2 * MiB, WS_SSQ2 = 3 * MiB, WS_SSQ3 = 4 * MiB;
constexpr size_t WS_WIN1 = 5 * MiB, WS_WOUT1 = 16 * MiB, WS_WMIX = 22 * MiB, WS_WA = 32 * MiB, WS_WB = 33 * MiB, WS_WO = 34 * MiB, WS_WIN2 = 36 * MiB, WS_WOUT2 = 47 * MiB;
constexpr size_t WS_XB = 53 * MiB;
constexpr size_t WS_R = 85 * MiB;
constexpr size_t WS_H = WS_R;
constexpr size_t WS_QQ = WS_R, WS_KA = WS_R + 32 * MiB, WS_VA = WS_R + 48 * MiB, WS_KB = WS_R + 64 * MiB, WS_VB = WS_R + 80 * MiB, WS_GA = WS_R + 96 * MiB, WS_GB = WS_R + 128 * MiB;
constexpr size_t WS_MG = WS_KA;
constexpr size_t WS_END = WS_R + 160 * MiB;
static_assert(WS_END <= 256 * MiB, "d_ws map");
static_assert(WS_WOUT2 + (size_t)DM * DFF * 2 <= WS_XB && WS_XB + (size_t)M * DM * 2 <= WS_R && WS_H + (size_t)M * DFF * 2 <= WS_END, "d_ws map");
constexpr int CW_BAR = 1024;

constexpr int RING_BYTES = 131072;
constexpr int LDSCTL_OFF = RING_BYTES, MISC_OFF = LDSCTL_OFF + 320;
constexpr int LDS_BYTES = 147456;

__device__ __forceinline__ unsigned cvt_pk_bf16(float lo, float hi) { f32x2 v = {lo, hi}; bf16x2_t b = __builtin_convertvector(v, bf16x2_t); return __builtin_bit_cast(unsigned, b); }
__device__ __forceinline__ float bf16lo(unsigned w) { return __uint_as_float(w << 16); }
__device__ __forceinline__ float bf16hi(unsigned w) { return __uint_as_float(w & 0xffff0000u); }
__device__ __forceinline__ float fast_rcp(float x) { return __builtin_amdgcn_rcpf(x); }
__device__ __forceinline__ float fast_exp2(float x) { return __builtin_amdgcn_exp2f(x); }
__device__ __forceinline__ float sigmoidf_(float v) { return fast_rcp(1.0f + fast_exp2(-v * LOG2E)); }
__device__ __forceinline__ float wave_sum(float v) {
#pragma unroll
    for (int o = 1; o < 64; o <<= 1) v += __shfl_xor(v, o);
    return v;
}
__device__ __forceinline__ float row_rstd(const float* ssq, int row) {
    const f32x4* p = (const f32x4*)(ssq + (size_t)row * 16);
    const f32x4 a = p[0], b = p[1], c = p[2], d = p[3];
    const float s = (((a.x + a.y) + (a.z + a.w)) + ((b.x + b.y) + (b.z + b.w))) + (((c.x + c.y) + (c.z + c.w)) + ((d.x + d.y) + (d.z + d.w)));
    return __builtin_amdgcn_rsqf(s * (1.0f / DM) + EPS);
}

namespace pg8 {
constexpr int BM = 256, BK = 64, HALF = 128, HTB = HALF * BK * 2, STAGE_BYTES = 8 * HTB, NXCD = 8, WGM = 8;
__host__ __device__ __forceinline__ int lds_byte(int r, int c) { const int st = (r >> 4) * 2 + (c >> 5), rr = r & 15, cc = c & 31, ob = rr * 64 + cc * 2; return st * 1024 + (ob ^ (((ob >> 9) & 1) << 5)); }
__host__ __device__ __forceinline__ void stage_rc(int b, int& R, int& C) { const int st = b / 1024, sb = b % 1024, swz = sb ^ (((sb >> 9) & 1) << 5); R = (st >> 1) * 16 + swz / 64; C = (st & 1) * 32 + (swz % 64) / 2; }
__host__ __device__ __forceinline__ int perm32(int rho) { const int n = rho >> 4, i = rho & 15; return 8 * (i >> 2) + 4 * n + (i & 3); }

struct Unit { int pm, pn, aux; };
struct Gemm { int lda, ldb, K; };

__device__ __forceinline__ void tile_of(int L, int nM, int nN, int& pm, int& pn) {
    const int nwg = nM * nN; int wgid = L;
    { const int q = nwg / NXCD, r = nwg % NXCD, xcd = wgid % NXCD, off = wgid / NXCD; wgid = (xcd < r ? xcd * (q + 1) : r * (q + 1) + (xcd - r) * q) + off; }
    const int nig = WGM * nN, gid = wgid / nig, fm = gid * WGM, gsz = (nM - fm) < WGM ? (nM - fm) : WGM;
    pm = fm + ((wgid % nig) % gsz); pn = (wgid % nig) / gsz;
}
struct StaticOrder {
    const bf16_t* A; const bf16_t* Bt; int lda, ldb, nM, nN, G, c;
    __device__ __forceinline__ bool next(int i, Unit& u) const { const long L = (long)i * G + c; if (L >= (long)nM * nN) return false; tile_of((int)L, nM, nN, u.pm, u.pn); u.aux = 0; return true; }
    __device__ __forceinline__ const char* aptr(const Unit& u) const { return (const char*)(A + (size_t)u.pm * BM * lda); }
    __device__ __forceinline__ const char* bptr(const Unit& u) const { return (const char*)(Bt + (size_t)u.pn * BM * ldb); }
};
struct BranchOrder {
    const bf16_t *A0, *A1, *B0, *B1; int lda, ldb, nM, nN, G, c;
    __device__ __forceinline__ bool next(int i, Unit& u) const { const long L = (long)(i >> 1) * G + c; if (L >= (long)nM * nN) return false; tile_of((int)L, nM, nN, u.pm, u.pn); u.aux = i & 1; return true; }
    __device__ __forceinline__ const char* aptr(const Unit& u) const { return (const char*)((u.aux ? A1 : A0) + (size_t)u.pm * BM * lda); }
    __device__ __forceinline__ const char* bptr(const Unit& u) const { return (const char*)((u.aux ? B1 : B0) + (size_t)u.pn * BM * ldb); }
};

typedef f32x4 Acc[2][2][4][2];

struct EpiSwiglu {
    static constexpr bool PERM = true;
    bf16_t* H; const float* ssq;
    __device__ __forceinline__ bool keep(const Unit&) const { return false; }
    __device__ __forceinline__ void operator()(Acc& acc, const Unit& u, int wr, int wc, int fr, int fq) const {
#pragma unroll
        for (int ai = 0; ai < 2; ++ai)
#pragma unroll
            for (int m = 0; m < 4; ++m) {
                const int row = u.pm * BM + ai * HALF + wr * 64 + m * 16 + fr; const float rs = row_rstd(ssq, row);
                float h[8];
#pragma unroll
                for (int n = 0; n < 2; ++n)
#pragma unroll
                    for (int e = 0; e < 4; ++e) { const float g = acc[ai][0][m][n][e] * rs, up = acc[ai][1][m][n][e] * rs; h[n * 4 + e] = g * sigmoidf_(g) * up; }
                u32x4 w; w.x = cvt_pk_bf16(h[0], h[1]); w.y = cvt_pk_bf16(h[2], h[3]); w.z = cvt_pk_bf16(h[4], h[5]); w.w = cvt_pk_bf16(h[6], h[7]);
                *(u32x4*)(H + (size_t)row * DFF + u.pn * HALF + wc * 32 + 8 * fq) = w;
            }
    }
};
template <bool BF>
struct EpiResid {
    static constexpr bool PERM = false;
    const void* base; float* out; bf16_t* xb; float* ssq; float alpha;
    __device__ __forceinline__ bool keep(const Unit&) const { return false; }
    __device__ __forceinline__ void operator()(Acc& acc, const Unit& u, int wr, int wc, int fr, int fq) const {
        const int col0 = u.pn * BM + wc * 32 + 4 * fq;
#pragma unroll
        for (int ai = 0; ai < 2; ++ai)
#pragma unroll
            for (int m = 0; m < 4; ++m) {
                const int row = u.pm * BM + ai * HALF + wr * 64 + m * 16 + fr; const size_t off = (size_t)row * DM + col0; float s = 0.f;
#pragma unroll
                for (int bj = 0; bj < 2; ++bj)
#pragma unroll
                    for (int n = 0; n < 2; ++n) {
                        f32x4 bs;
                        if (BF) { const u32x2 t = *(const u32x2*)((const bf16_t*)base + off + bj * HALF + n * 16); bs = (f32x4){bf16lo(t.x), bf16hi(t.x), bf16lo(t.y), bf16hi(t.y)}; }
                        else bs = *(const f32x4*)((const float*)base + off + bj * HALF + n * 16);
                        const f32x4 v = bs + acc[ai][bj][m][n] * alpha;
                        if (out) *(f32x4*)(out + off + bj * HALF + n * 16) = v;
                        s += (v.x * v.x + v.y * v.y) + (v.z * v.z + v.w * v.w);
                        if (xb) { u32x2 w; w.x = cvt_pk_bf16(v.x, v.y); w.y = cvt_pk_bf16(v.z, v.w); *(u32x2*)(xb + off + bj * HALF + n * 16) = w; }
                    }
                s += __shfl_xor(s, 16); s += __shfl_xor(s, 32);
                if (fq == 0) ssq[(size_t)row * 16 + u.pn * 4 + wc] = s;
            }
    }
};
struct EpiMix {
    static constexpr bool PERM = true;
    bf16_t *QQ, *KA, *VA, *KB, *VB, *GA, *GB; const float* ssq; const float* bgate;
    __device__ __forceinline__ bool keep(const Unit&) const { return false; }
    __device__ __forceinline__ void operator()(Acc& acc, const Unit& u, int wr, int wc, int fr, int fq) const {
        const int pn = u.pn; bf16_t* dst; int ld; float sc = 1.f; bool gate = false; int gcol = 0;
        if (pn < 2) { dst = QQ + pn * 256; ld = 1024; sc = QSCALE; }
        else if (pn < 4) { dst = KA + (pn - 2) * 256; ld = 512; }
        else if (pn < 6) { dst = VA + (pn - 4) * 256; ld = 512; }
        else if (pn < 8) { dst = QQ + 512 + (pn - 6) * 256; ld = 1024; sc = QSCALE; }
        else if (pn < 10) { dst = KB + (pn - 8) * 256; ld = 512; }
        else if (pn < 12) { dst = VB + (pn - 10) * 256; ld = 512; }
        else if (pn < 16) { dst = GA + (pn - 12) * 256; ld = 1024; gate = true; gcol = (pn - 12) * 256; }
        else { dst = GB + (pn - 16) * 256; ld = 1024; gate = true; gcol = (pn - 12) * 256; }
        const int cw = wc * 32 + 8 * fq;
        f32x4 bv[2][2];
#pragma unroll
        for (int bj = 0; bj < 2; ++bj)
#pragma unroll
            for (int n = 0; n < 2; ++n) bv[bj][n] = gate ? *(const f32x4*)(bgate + gcol + bj * HALF + cw + 4 * n) : (f32x4){0.f, 0.f, 0.f, 0.f};
#pragma unroll
        for (int ai = 0; ai < 2; ++ai)
#pragma unroll
            for (int m = 0; m < 4; ++m) {
                const int row = u.pm * BM + ai * HALF + wr * 64 + m * 16 + fr; const float rs = row_rstd(ssq, row) * sc;
                bf16_t* rowp = dst + (size_t)row * ld + cw;
#pragma unroll
                for (int bj = 0; bj < 2; ++bj) {
                    f32x4 v0 = acc[ai][bj][m][0] * rs, v1 = acc[ai][bj][m][1] * rs;
                    if (gate) {
                        v0 = v0 + bv[bj][0]; v1 = v1 + bv[bj][1];
                        v0 = (f32x4){sigmoidf_(v0.x), sigmoidf_(v0.y), sigmoidf_(v0.z), sigmoidf_(v0.w)}; v1 = (f32x4){sigmoidf_(v1.x), sigmoidf_(v1.y), sigmoidf_(v1.z), sigmoidf_(v1.w)};
                    }
                    u32x4 w; w.x = cvt_pk_bf16(v0.x, v0.y); w.y = cvt_pk_bf16(v0.z, v0.w); w.z = cvt_pk_bf16(v1.x, v1.y); w.w = cvt_pk_bf16(v1.z, v1.w);
                    *(u32x4*)(rowp + bj * HALF) = w;
                }
            }
    }
};
struct EpiBranch {
    static constexpr bool PERM = true;
    const bf16_t *GA, *GB; bf16_t* MG;
    __device__ __forceinline__ bool keep(const Unit& u) const { return u.aux == 0; }
    __device__ __forceinline__ void operator()(Acc& acc, const Unit& u, int wr, int wc, int fr, int fq) const {
        const int col0 = u.pn * BM + wc * 32 + 8 * fq;
#pragma unroll
        for (int ai = 0; ai < 2; ++ai)
#pragma unroll
            for (int m = 0; m < 4; ++m) {
                const int row = u.pm * BM + ai * HALF + wr * 64 + m * 16 + fr; const size_t off = (size_t)row * DM + col0;
#pragma unroll
                for (int bj = 0; bj < 2; ++bj) {
                    const u32x4 gb = *(const u32x4*)(GB + off + bj * HALF);
                    float b[8] = {bf16lo(gb.x), bf16hi(gb.x), bf16lo(gb.y), bf16hi(gb.y), bf16lo(gb.z), bf16hi(gb.z), bf16lo(gb.w), bf16hi(gb.w)};
#pragma unroll
                    for (int e = 0; e < 8; ++e) b[e] = fmaxf(b[e], 1e-30f);
                    if (u.aux == 0) {
                        const u32x4 ga = *(const u32x4*)(GA + off + bj * HALF);
                        const float a[8] = {bf16lo(ga.x), bf16hi(ga.x), bf16lo(ga.y), bf16hi(ga.y), bf16lo(ga.z), bf16hi(ga.z), bf16lo(ga.w), bf16hi(ga.w)};
#pragma unroll
                        for (int e = 0; e < 8; ++e) acc[ai][bj][m][e >> 2][e & 3] *= a[e] / b[e];
                    } else {
                        float v[8];
#pragma unroll
                        for (int e = 0; e < 8; ++e) v[e] = acc[ai][bj][m][e >> 2][e & 3] * b[e];
                        u32x4 w; w.x = cvt_pk_bf16(v[0], v[1]); w.y = cvt_pk_bf16(v[2], v[3]); w.z = cvt_pk_bf16(v[4], v[5]); w.w = cvt_pk_bf16(v[6], v[7]);
                        *(u32x4*)(MG + off + bj * HALF) = w;
                    }
                }
            }
    }
};

template <class Epi, class Sched>
__device__ __forceinline__ void gemm_phase(LAS unsigned char* lds, const Gemm g, const Sched& S, const Epi& E) {
    const int tid = threadIdx.x, wid = __builtin_amdgcn_readfirstlane(tid >> 6), lane = tid & 63, wr = wid >> 2, wc = wid & 3, fr = lane & 15, fq = lane >> 4;
    const int K = g.K, nt = K / BK;
    unsigned voffA[2], voffB[2];
#pragma unroll
    for (int i = 0; i < 2; ++i) { int R, C; stage_rc(tid * 16 + i * 8192, R, C); const int Rb = Epi::PERM ? ((R & ~31) + perm32(R & 31)) : R;
        voffA[i] = (unsigned)(R * g.lda + C) * 2u; voffB[i] = (unsigned)(Rb * g.ldb + C) * 2u; }
    const size_t kstep = (size_t)(BK * 2);
    const size_t hstepA = (size_t)HALF * g.lda * 2, hstepB = (size_t)HALF * g.ldb * 2;
    const unsigned ldsw = (unsigned)wid * 1024u;
    const int aoff = lds_byte(wr * 64 + fr, fq * 8), boff = lds_byte(wc * 32 + fr, fq * 8);
#define PG8_SA(b, h) (((b) * 2 + (h)) * HTB)
#define PG8_SB(b, h) ((4 + (b) * 2 + (h)) * HTB)
#define PG8_STAGE(bufoff, gbase, voff) do { _Pragma("unroll") for (int _i = 0; _i < 2; ++_i) \
        __builtin_amdgcn_global_load_lds((const unsigned*)((const char*)(gbase) + (voff)[_i]), (LAS unsigned*)(lds + (bufoff) + ldsw + _i * 8192), 16, 0, 0); } while (0)
#define PG8_LDA(dst, b, h) do { _Pragma("unroll") for (int m = 0; m < 4; ++m) _Pragma("unroll") for (int k = 0; k < 2; ++k) dst[m][k] = *(const LAS bf16x8*)(lds + PG8_SA(b, h) + aoff + m * 2048 + k * 1024); } while (0)
#define PG8_LDB(dst, b, h) do { _Pragma("unroll") for (int n = 0; n < 2; ++n) _Pragma("unroll") for (int k = 0; k < 2; ++k) dst[n][k] = *(const LAS bf16x8*)(lds + PG8_SB(b, h) + boff + n * 2048 + k * 1024); } while (0)
#define PG8_MMA(ai, bj, At, Bt) do { __builtin_amdgcn_s_setprio(1); _Pragma("unroll") for (int m = 0; m < 4; ++m) _Pragma("unroll") for (int n = 0; n < 2; ++n) _Pragma("unroll") for (int k = 0; k < 2; ++k) \
        acc[ai][bj][m][n] = __builtin_amdgcn_mfma_f32_16x16x32_bf16(Bt[n][k], At[m][k], acc[ai][bj][m][n], 0, 0, 0); __builtin_amdgcn_s_setprio(0); } while (0)
#define PG8_WAIT_V(n) asm volatile("s_waitcnt vmcnt(" #n ")" ::: "memory")
#define PG8_WAIT_L(n) asm volatile("s_waitcnt lgkmcnt(" #n ")" ::: "memory")
#define PG8_BAR __builtin_amdgcn_s_barrier()
#define PG8_SCHED __builtin_amdgcn_sched_barrier(0)
    Unit cur, nxt; int ui = 0;
    if (!S.next(0, cur)) return;
    Acc acc;
#pragma unroll
    for (int a = 0; a < 2; ++a)
#pragma unroll
        for (int b = 0; b < 2; ++b)
#pragma unroll
            for (int m = 0; m < 4; ++m)
#pragma unroll
                for (int n = 0; n < 2; ++n) acc[a][b][m][n] = (f32x4){0.f, 0.f, 0.f, 0.f};
    bf16x8 At[4][2], B0[2][2], B1[2][2];
    const char* cA = S.aptr(cur); const char* cB = S.bptr(cur);
    PG8_STAGE(PG8_SB(0, 0), cB, voffB); PG8_STAGE(PG8_SB(0, 1), cB + hstepB, voffB); PG8_STAGE(PG8_SA(0, 0), cA, voffA); PG8_STAGE(PG8_SA(0, 1), cA + hstepA, voffA);
    if (wr == 1) PG8_BAR;
    PG8_WAIT_V(2); PG8_BAR;
    PG8_STAGE(PG8_SB(1, 0), cB + kstep, voffB); PG8_STAGE(PG8_SA(1, 0), cA + kstep, voffA); PG8_STAGE(PG8_SB(1, 1), cB + hstepB + kstep, voffB);
    PG8_WAIT_V(6); PG8_BAR;
    for (;;) {
        const bool has_next = S.next(ui + 1, nxt);
        const char* nA = has_next ? S.aptr(nxt) : cA; const char* nB = has_next ? S.bptr(nxt) : cB;
        for (int t = 0; t < nt; t += 2) {
            const bool last = (t == nt - 2);
            const char* a1 = cA + (size_t)(t + 1) * kstep;
            const char* a2 = last ? nA : cA + (size_t)(t + 2) * kstep; const char* b2 = last ? nB : cB + (size_t)(t + 2) * kstep;
            const char* a3 = a2 + kstep; const char* b3 = b2 + kstep;
            PG8_LDB(B0, 0, 0); PG8_LDB(B1, 0, 1); PG8_SCHED; PG8_LDA(At, 0, 0); PG8_STAGE(PG8_SA(1, 1), a1 + hstepA, voffA);
            PG8_WAIT_V(8); PG8_WAIT_L(0); PG8_BAR; PG8_MMA(0, 0, At, B0); PG8_MMA(0, 1, At, B1); PG8_BAR; PG8_SCHED;
            PG8_LDA(At, 0, 1); PG8_STAGE(PG8_SB(0, 0), b2, voffB); PG8_STAGE(PG8_SB(0, 1), b2 + hstepB, voffB); PG8_STAGE(PG8_SA(0, 0), a2, voffA);
            PG8_WAIT_V(8); PG8_WAIT_L(0); PG8_BAR; PG8_MMA(1, 0, At, B0); PG8_MMA(1, 1, At, B1); PG8_BAR; PG8_SCHED;
            PG8_LDB(B0, 1, 0); PG8_LDB(B1, 1, 1); PG8_SCHED; PG8_LDA(At, 1, 0); PG8_STAGE(PG8_SA(0, 1), a2 + hstepA, voffA);
            PG8_WAIT_V(8); PG8_WAIT_L(0); PG8_BAR; PG8_MMA(0, 0, At, B0); PG8_MMA(0, 1, At, B1); PG8_BAR; PG8_SCHED;
            PG8_LDA(At, 1, 1); PG8_STAGE(PG8_SB(1, 0), b3, voffB); PG8_STAGE(PG8_SB(1, 1), b3 + hstepB, voffB); PG8_STAGE(PG8_SA(1, 0), a3, voffA);
            PG8_WAIT_V(8); PG8_WAIT_L(0); PG8_BAR; PG8_MMA(1, 0, At, B0); PG8_MMA(1, 1, At, B1); PG8_BAR; PG8_SCHED;
        }
        if (wr == 0) PG8_BAR;
        E(acc, cur, wr, wc, fr, fq);
        if (!has_next) break;
        if (!E.keep(cur)) {
#pragma unroll
            for (int a = 0; a < 2; ++a)
#pragma unroll
                for (int b = 0; b < 2; ++b)
#pragma unroll
                    for (int m = 0; m < 4; ++m)
#pragma unroll
                        for (int n = 0; n < 2; ++n) acc[a][b][m][n] = (f32x4){0.f, 0.f, 0.f, 0.f};
        }
        cur = nxt; cA = nA; cB = nB; ++ui;
        if (wr == 1) PG8_BAR;
    }
    PG8_WAIT_V(0);
    PG8_BAR;
#undef PG8_SA
#undef PG8_SB
#undef PG8_STAGE
#undef PG8_LDA
#undef PG8_LDB
#undef PG8_MMA
#undef PG8_WAIT_V
#undef PG8_WAIT_L
#undef PG8_BAR
#undef PG8_SCHED
}
}

namespace att {
constexpr int STG = 32768, L_TAB = 3 * STG, L_WSF = L_TAB + 2048, L_END = L_WSF + 2048;
static_assert(L_END <= RING_BYTES, "attention LDS");
__device__ __forceinline__ int crow(int r, int hi) { return (r & 3) + 8 * (r >> 2) + 4 * hi; }
__device__ __forceinline__ float max3f(float a, float b, float c) { float r; asm("v_max3_f32 %0, %1, %2, %3" : "=v"(r) : "v"(a), "v"(b), "v"(c)); return r; }
#define ATT_SBAR() __builtin_amdgcn_sched_barrier(0)
__device__ __forceinline__ s16x4 vtr(const LAS char* p) { return __builtin_bit_cast(s16x4, __builtin_amdgcn_ds_read_tr16_b64_v4i16((LAS s16x4*)p)); }
__device__ __forceinline__ int t5_bucket(int rel) {
    const int n = rel < 0 ? -rel : rel;
    const int large = 8 + (n >= 12) + (n >= 16) + (n >= 23) + (n >= 32) + (n >= 46) + (n >= 64) + (n >= 91);
    return (rel > 0 ? 16 : 0) + (n < 8 ? n : large);
}
struct Params {
    const bf16_t* QQ; const bf16_t *KA, *VA, *KB, *VB; bf16_t* Y;
    const float *relA, *t5, *lq1, *lk1, *lq2, *lk2, *subg;
};

template <int MODE, int PRB = 0>
__device__ __forceinline__ void unit(LAS char* lds, const Params& P, int b, int hp, int qb) {
    constexpr int NDB = MODE == 0 ? 2 : 4;
    const int tid = threadIdx.x, lane = tid & 63, r32 = lane & 31, hi = lane >> 5;
    const int w = __builtin_amdgcn_readfirstlane(tid >> 6), g = w >> 2, wq = w & 3;
    const bf16_t* Kslab = (MODE == 0 ? P.KA : P.KB) + (size_t)b * SEQ * 512 + hp * 128;
    const bf16_t* Vslab = (MODE == 0 ? P.VA : P.VB) + (size_t)b * SEQ * 512 + hp * 128;
    const int qcol = (MODE == 0 ? 0 : 512) + hp * 128;
    const int qrow0 = qb * 128 + wq * 32;
    const size_t grow0 = (size_t)b * SEQ + qrow0;
    const int cq = qrow0 >> 6;
    const int t_hi = 2 * qb + 1, t_lo = MODE == 0 ? (2 * qb - 8 > 0 ? 2 * qb - 8 : 0) : 0;
    const int w_lo = MODE == 0 ? cq - 8 : 0;
    LAS float* tab = (LAS float*)(lds + L_TAB);
    if (tid < 512) {
        const int gg = tid >> 8, idx = tid & 255, rel = idx - 191; float v;
        if (MODE == 0) { const float* tb = P.relA + (2 * hp + gg) * 257; const int rc = rel < -128 ? -128 : (rel > 128 ? 128 : rel); v = (tb[rc + 128] - tb[0]) * LOG2E; }
        else { const float* tb = P.t5 + hp * 32; v = (tb[t5_bucket(rel)] - tb[15]) * LOG2E; }
        tab[gg * 256 + idx] = v;
    }
    bf16x8 qf[4];
#pragma unroll
    for (int s = 0; s < 4; ++s) qf[s] = *(const bf16x8*)(P.QQ + (grow0 + r32) * 1024 + qcol + 64 * g + 16 * s + 8 * hi);
    const int prow = 4 * w + (lane >> 4), pj = lane & 15;
    const bf16_t* ksrc = Kslab + (size_t)prow * 512 + (pj ^ (prow & 15)) * 8;
    const bf16_t* vsrc = Vslab + (size_t)prow * 512 + (((pj >> 2) ^ (prow & 3)) * 4 + (pj & 3)) * 8;
    const unsigned lds0 = (unsigned)(unsigned long)(LAS char*)lds;
#define ATT_GLDS(gsrc, ldsdst) do { unsigned keep_; asm volatile("s_mov_b32 %0, m0\n\ts_mov_b32 m0, %2\n\ts_nop 0\n\tglobal_load_lds_dwordx4 %1, off\n\ts_mov_b32 m0, %0" \
        : "=&s"(keep_) : "v"(gsrc), "s"((unsigned)__builtin_amdgcn_readfirstlane((int)(ldsdst))) : "memory"); } while (0)
#define ATT_STAGE(t, boff) do { const size_t ro_ = (size_t)(t) * 64 * 512; \
        ATT_GLDS(ksrc + ro_, lds0 + (boff) + w * 1024); ATT_GLDS(ksrc + ro_ + 32 * 512, lds0 + (boff) + (w + 8) * 1024); \
        ATT_GLDS(vsrc + ro_, lds0 + (boff) + 16384 + w * 1024); ATT_GLDS(vsrc + ro_ + 32 * 512, lds0 + (boff) + 16384 + (w + 8) * 1024); } while (0)
    if (!(PRB & 1)) { ATT_STAGE(t_lo, 0);
    if (t_lo < t_hi) ATT_STAGE(t_lo + 1, STG); }
#pragma unroll
    for (int s = 0; s < 4; ++s) asm volatile("" : "+v"(qf[s]));
    f32x16 o[NDB];
#pragma unroll
    for (int d = 0; d < NDB; ++d) o[d] = (f32x16){};
    float mrun = 0.f, lrun = 0.f;
    const int tfirst = w_lo > t_lo ? w_lo : t_lo;
    LAS float* wsf = (LAS float*)(lds + L_WSF) + w * 64;
    int koff[4], voff[NDB];
#pragma unroll
    for (int s = 0; s < 4; ++s) koff[s] = r32 * 256 + 16 * ((8 * g + 2 * s + hi) ^ (r32 & 15));
    { const int q = (lane & 15) >> 2;
#pragma unroll
      for (int d = 0; d < NDB; ++d) voff[d] = 16384 + (4 * hi + q) * 256 + 64 * (((MODE == 0 ? 2 * g : 0) + d) ^ q) + ((lane >> 4) & 1) * 32 + (lane & 3) * 8; }
    int boff = 0, bnext = 2 * STG;
    for (int t = t_lo; t <= t_hi; ++t) {
        if (t < t_hi) asm volatile("s_waitcnt vmcnt(4)" ::: "memory"); else asm volatile("s_waitcnt vmcnt(0)" ::: "memory");
        __builtin_amdgcn_s_barrier(); asm volatile("" ::: "memory");
        if (!(PRB & 1) && t + 2 <= t_hi) ATT_STAGE(t + 2, bnext);
        if (!(PRB & 2) && t >= w_lo && t <= cq) {
            const LAS char* tb_ = lds + boff;
            bf16x8 kf[8];
#pragma unroll
            for (int i = 0; i < 8; ++i) kf[i] = *(const LAS bf16x8*)(tb_ + koff[i >> 1] + (i & 1) * 8192);
            s16x4 va[16];
#pragma unroll
            for (int i = 0; i < 8; ++i) { va[2 * i] = vtr(tb_ + voff[i >> 2] + (i & 3) * 4096); va[2 * i + 1] = vtr(tb_ + voff[i >> 2] + (i & 3) * 4096 + 2048); }
            ATT_SBAR();
            f32x16 s0 = (f32x16){}, s1 = (f32x16){};
#pragma unroll
            for (int s = 0; s < 4; ++s) {
                s0 = __builtin_amdgcn_mfma_f32_32x32x16_bf16(kf[2 * s], qf[s], s0, 0, 0, 0); s1 = __builtin_amdgcn_mfma_f32_32x32x16_bf16(kf[2 * s + 1], qf[s], s1, 0, 0, 0);
            }
            if (t >= cq - 2) {
                const LAS float* tb = tab + (MODE == 0 ? g * 256 : 0) + (64 * t - (qrow0 + r32) + 191 + 4 * hi);
#pragma unroll
                for (int r = 0; r < 16; ++r) { s0[r] += tb[(r & 3) + 8 * (r >> 2)]; s1[r] += tb[32 + (r & 3) + 8 * (r >> 2)]; }
            }
#pragma unroll
            for (int r = 0; r < 16; ++r) { s0[r] -= mrun; s1[r] -= mrun; }
            float rm = max3f(s0[0], s0[1], s1[0]), rm2 = max3f(s0[2], s0[3], s1[1]); rm = max3f(rm, s1[2], s1[3]);
#pragma unroll
            for (int r = 4; r < 16; r += 4) { rm = max3f(rm, s0[r], s0[r + 1]); rm2 = max3f(rm2, s0[r + 2], s0[r + 3]); rm = max3f(rm, s1[r], s1[r + 1]); rm2 = max3f(rm2, s1[r + 2], s1[r + 3]); }
            rm = max3f(rm, rm2, rm2);
            { auto rr = __builtin_amdgcn_permlane32_swap(__float_as_uint(rm), __float_as_uint(rm), false, false); rm = max3f(__uint_as_float(rr[0]), __uint_as_float(rr[1]), rm); }
            const bool first = (t == tfirst);
            if (__any(rm > 8.0f) || first) {
                const float dl = first ? rm : fmaxf(rm, 0.f), al = first ? 0.f : fast_exp2(-dl);
                lrun *= al; mrun += dl;
#pragma unroll
                for (int r = 0; r < 16; ++r) { s0[r] -= dl; s1[r] -= dl; }
                if (hi == 0) wsf[r32] = al;
                __builtin_amdgcn_wave_barrier();
#pragma unroll
                for (int r = 0; r < 16; ++r) { const float f = wsf[crow(r, hi)];
#pragma unroll
                    for (int d = 0; d < NDB; ++d) o[d][r] *= f; }
                __builtin_amdgcn_wave_barrier();
            }
            float ls = 0.f;
#pragma unroll
            for (int r = 0; r < 16; ++r) { s0[r] = fast_exp2(s0[r]); s1[r] = fast_exp2(s1[r]); ls += s0[r] + s1[r]; }
            lrun += ls;
            bf16x8 pa[4];
            { u32x4 t0, t1, t2, t3;
              t0.x = cvt_pk_bf16(s0[0], s0[1]); t0.y = cvt_pk_bf16(s0[2], s0[3]); t0.z = cvt_pk_bf16(s0[4], s0[5]); t0.w = cvt_pk_bf16(s0[6], s0[7]);
              t1.x = cvt_pk_bf16(s0[8], s0[9]); t1.y = cvt_pk_bf16(s0[10], s0[11]); t1.z = cvt_pk_bf16(s0[12], s0[13]); t1.w = cvt_pk_bf16(s0[14], s0[15]);
              t2.x = cvt_pk_bf16(s1[0], s1[1]); t2.y = cvt_pk_bf16(s1[2], s1[3]); t2.z = cvt_pk_bf16(s1[4], s1[5]); t2.w = cvt_pk_bf16(s1[6], s1[7]);
              t3.x = cvt_pk_bf16(s1[8], s1[9]); t3.y = cvt_pk_bf16(s1[10], s1[11]); t3.z = cvt_pk_bf16(s1[12], s1[13]); t3.w = cvt_pk_bf16(s1[14], s1[15]);
              pa[0] = __builtin_bit_cast(bf16x8, t0); pa[1] = __builtin_bit_cast(bf16x8, t1); pa[2] = __builtin_bit_cast(bf16x8, t2); pa[3] = __builtin_bit_cast(bf16x8, t3); }
            ATT_SBAR();
            s16x4 vc[NDB == 4 ? 16 : 1];
            if (NDB == 4) {
#pragma unroll
                for (int i = 0; i < 8; ++i) { vc[2 * i] = vtr(tb_ + voff[NDB - 2 + (i >> 2)] + (i & 3) * 4096); vc[2 * i + 1] = vtr(tb_ + voff[NDB - 2 + (i >> 2)] + (i & 3) * 4096 + 2048); }
                ATT_SBAR();
            }
#define ATT_VF(arr, i) (bf16x8){arr[2 * (i)][0], arr[2 * (i)][1], arr[2 * (i)][2], arr[2 * (i)][3], arr[2 * (i) + 1][0], arr[2 * (i) + 1][1], arr[2 * (i) + 1][2], arr[2 * (i) + 1][3]}
#pragma unroll
            for (int ks = 0; ks < 4; ++ks) {
                o[0] = __builtin_amdgcn_mfma_f32_32x32x16_bf16(pa[ks], ATT_VF(va, ks), o[0], 0, 0, 0);
                o[1] = __builtin_amdgcn_mfma_f32_32x32x16_bf16(pa[ks], ATT_VF(va, 4 + ks), o[1], 0, 0, 0);
            }
            if (NDB == 4) {
#pragma unroll
                for (int ks = 0; ks < 4; ++ks) {
                    o[NDB - 2] = __builtin_amdgcn_mfma_f32_32x32x16_bf16(pa[ks], ATT_VF(vc, ks), o[NDB - 2], 0, 0, 0);
                    o[NDB - 1] = __builtin_amdgcn_mfma_f32_32x32x16_bf16(pa[ks], ATT_VF(vc, 4 + ks), o[NDB - 1], 0, 0, 0);
                }
            }
#undef ATT_VF
        }
        boff = (boff == 2 * STG) ? 0 : boff + STG; bnext = (bnext == 2 * STG) ? 0 : bnext + STG;
    }
    asm volatile("s_waitcnt lgkmcnt(0)" ::: "memory"); __builtin_amdgcn_s_barrier(); asm volatile("" ::: "memory");
#undef ATT_STAGE
#undef ATT_GLDS
    if (PRB & 4) { if (lane == 0 && o[0][0] == 123.f) P.Y[0] = 0; return; }
    const float lt = lrun + __shfl_xor(lrun, 32);
    if (hi == 0) wsf[32 + r32] = fast_rcp(lt);
    __builtin_amdgcn_wave_barrier();
    float inv[16];
#pragma unroll
    for (int r = 0; r < 16; ++r) inv[r] = wsf[32 + crow(r, hi)];
    if (MODE == 0) {
        bf16_t* yo = P.Y + grow0 * 1024 + qcol + 64 * g + r32;
#pragma unroll
        for (int r = 0; r < 16; ++r)
#pragma unroll
            for (int d = 0; d < NDB; ++d) yo[(size_t)crow(r, hi) * 1024 + 32 * d] = (bf16_t)(cvt_pk_bf16(o[d][r] * inv[r], 0.f) & 0xffffu);
        __syncthreads();
    } else {
        const float s1 = wave_sum(P.lq1[lane] * P.lk1[lane]), s2 = wave_sum(P.lq2[lane] * P.lk2[lane]);
        const float lam = __expf(s1) - __expf(s2) + 0.2f;
        LAS float* X = (LAS float*)lds;
        if (g == 1) {
#pragma unroll
            for (int r = 0; r < 16; ++r)
#pragma unroll
                for (int d = 0; d < 4; ++d) X[((wq * 16 + r) * 4 + d) * 64 + lane] = o[d][r] * inv[r] * lam;
        }
        __syncthreads();
        if (g == 0) {
            float sg[4];
#pragma unroll
            for (int d = 0; d < 4; ++d) sg[d] = P.subg[32 * d + r32] * 0.8f;
            bf16_t* yo = P.Y + grow0 * 1024 + qcol + r32;
#pragma unroll
            for (int r = 0; r < 16; ++r) {
                float dv[4]; float ss = 0.f;
#pragma unroll
                for (int d = 0; d < 4; ++d) { dv[d] = o[d][r] * inv[r] - X[((wq * 16 + r) * 4 + d) * 64 + lane]; ss += dv[d] * dv[d]; }
                ss += __shfl_xor(ss, 1); ss += __shfl_xor(ss, 2); ss += __shfl_xor(ss, 4); ss += __shfl_xor(ss, 8); ss += __shfl_xor(ss, 16);
                const float rn = __builtin_amdgcn_rsqf(ss * (1.0f / 128.0f) + EPS);
#pragma unroll
                for (int d = 0; d < 4; ++d) yo[(size_t)crow(r, hi) * 1024 + 32 * d] = (bf16_t)(cvt_pk_bf16(dv[d] * rn * sg[d], 0.f) & 0xffffu);
            }
        }
        __syncthreads();
    }
}
}

typedef GAS unsigned gu32;
#define XB_TMO      128
#define XB_XCNT(j)  (256  + 64 * (j))
#define XB_XSUB(j)  (1280 + 64 * (j))
#define XB_XGEN(j)  (2304 + 64 * (j))
#define XB_TOP      3328
#define XB_TOPGEN   3392
#define XCD_BAR_WORDS 3456
#define XB_SPIN_CAP (1u << 18)
__device__ __forceinline__ unsigned xb_ld(unsigned* p)              { return __hip_atomic_load(p, __ATOMIC_RELAXED, __HIP_MEMORY_SCOPE_AGENT); }
__device__ __forceinline__ unsigned xb_add(unsigned* p, unsigned v) { return __hip_atomic_fetch_add(p, v, __ATOMIC_RELAXED, __HIP_MEMORY_SCOPE_AGENT); }
__device__ __forceinline__ unsigned xb_xcc_id() { return (unsigned)__builtin_amdgcn_s_getreg((3 << 11) | 20) & 0xFu; }
#define XB_SPIN(cond, bar) do { unsigned _sp = 0; while (cond) { __builtin_amdgcn_s_sleep(1); \
    if ((++_sp & 255u) == 0u) { if (xb_ld(&(bar)[XB_TMO])) break; if (_sp > XB_SPIN_CAP) { atomicAdd(&(bar)[XB_TMO], 1u); break; } } } } while (0)
struct XcdBarrier { unsigned* bar; unsigned x; volatile LAS unsigned* st; };
__device__ __forceinline__ XcdBarrier xcd_barrier_post(unsigned* bar, volatile LAS unsigned* st) {
    XcdBarrier b; b.bar = bar; b.x = xb_xcc_id(); b.st = st;
    if (threadIdx.x == 0) (void)xb_add(&bar[XB_XCNT(b.x)], 1u);
    return b;
}
__device__ __forceinline__ void xcd_barrier_complete(unsigned* bar, unsigned x, unsigned& nloc, unsigned& nx) {
    const unsigned G = gridDim.x * gridDim.y * gridDim.z;
    unsigned sum, cnt, mine, sp = 0u;
    for (;;) {
        sum = 0u; cnt = 0u; mine = 0u;
#pragma unroll
        for (unsigned j = 0; j < 16; ++j) { const unsigned c = xb_ld(&bar[XB_XCNT(j)]); sum += c; cnt += (c > 0u) ? 1u : 0u; mine = (j == x) ? c : mine; }
        if (sum == G) break;
        __builtin_amdgcn_s_sleep(1);
        if ((++sp & 255u) == 0u) { if (xb_ld(&bar[XB_TMO])) break; if (sp > XB_SPIN_CAP) { atomicAdd(&bar[XB_TMO], 1u); break; } }
    }
    nloc = mine > 0u ? mine : 1u; nx = cnt > 0u ? cnt : 1u;
}
__device__ __forceinline__ void xcd_barrier(const XcdBarrier& b) {
    asm volatile("s_waitcnt vmcnt(0)" ::: "memory");
    __syncthreads();
    if (threadIdx.x == 0) {
        unsigned* bar = b.bar;
        __builtin_amdgcn_s_waitcnt(0);
        unsigned nloc = b.st[0], nx = b.st[1];
        if (nloc == 0u) { xcd_barrier_complete(bar, b.x, nloc, nx); b.st[0] = nloc; b.st[1] = nx; }
        const unsigned old = xb_add(&bar[XB_XSUB(b.x)], 1u);
        const unsigned gen = old / nloc;
        if (old + 1u == (gen + 1u) * nloc) {
            __builtin_amdgcn_fence(__ATOMIC_RELEASE, "agent");
            asm volatile("s_waitcnt vmcnt(0)" ::: "memory");
            const unsigned og = xb_add(&bar[XB_TOP], 1u);
            const unsigned tg = og / nx;
            if (og + 1u == (tg + 1u) * nx) xb_add(&bar[XB_TOPGEN], 1u);
            else XB_SPIN(xb_ld(&bar[XB_TOPGEN]) == tg, bar);
            __builtin_amdgcn_fence(__ATOMIC_ACQUIRE, "agent");
            xb_add(&bar[XB_XGEN(b.x)], 1u);
            asm volatile("s_waitcnt vmcnt(0)" ::: "memory");
        } else {
            XB_SPIN(xb_ld(&bar[XB_XGEN(b.x)]) == gen, bar);
            __builtin_amdgcn_fence(__ATOMIC_ACQUIRE, "agent");
            asm volatile("s_waitcnt vmcnt(0)" ::: "memory");
        }
    }
    __syncthreads();
}

__device__ __forceinline__ unsigned f2bf(float f) { unsigned u = __builtin_bit_cast(unsigned, f); return (u + 0x7fffu + ((u >> 16) & 1u)) >> 16; }
__device__ __forceinline__ unsigned pk2(float lo, float hi) { return f2bf(lo) | (f2bf(hi) << 16); }
template <bool SWI, bool GAIN>
__device__ __forceinline__ void p0_transpose_item(const float* W, int K, int N, const float* gain, bf16_t* WT, LAS float* scr, int item, int lane) {
    const int nblk = N / 32, kb = item / nblk, nb = item % nblk, k0 = 64 * kb, n0 = 32 * nb;
#pragma unroll 8
    for (int i = 0; i < 32; ++i) { const int kk = 2 * i + (lane >> 5); const float gk = GAIN ? gain[k0 + kk] : 1.0f; scr[kk * 33 + (lane & 31)] = W[(size_t)(k0 + kk) * N + n0 + (lane & 31)] * gk; }
    asm volatile("s_waitcnt lgkmcnt(0)" ::: "memory");
    int r0 = n0;
    if (SWI) { const int half = n0 >= DFF, nn = n0 - half * DFF; r0 = (nn >> 7) * 256 + half * 128 + (nn & 127); }
    const int c = lane & 7;
#pragma unroll
    for (int j = 0; j < 4; ++j) { const int n = (lane >> 3) + 8 * j; const LAS float* s = scr + (8 * c) * 33 + n;
        u32x4 o; o.x = pk2(s[0 * 33], s[1 * 33]); o.y = pk2(s[2 * 33], s[3 * 33]); o.z = pk2(s[4 * 33], s[5 * 33]); o.w = pk2(s[6 * 33], s[7 * 33]);
        *(GAS u32x4*)(WT + (size_t)(r0 + n) * K + k0 + 8 * c) = o; }
    asm volatile("s_waitcnt lgkmcnt(0)" ::: "memory");
}

constexpr int N_PHASES = 10;
struct Args { const float* in[21]; float* out; unsigned char* ws; int ph_lo, ph_hi; };
static_assert(sizeof(Args) == 21 * 8 + 8 + 8 + 8, "Args has no padding");

__global__ void __launch_bounds__(NWAVES * 64, 2) fwd_kernel(Args args) {
    extern __shared__ __attribute__((aligned(16))) unsigned char lds_raw[];
    LAS unsigned char* lds = (LAS unsigned char*)lds_raw;
    volatile LAS unsigned* MISC = (volatile LAS unsigned*)(lds + MISC_OFF);
    const int tid = threadIdx.x, lane = tid & 63, wave = __builtin_amdgcn_readfirstlane(tid >> 6);
    const int G = gridDim.x, bx = blockIdx.x;
    const int vcu = (G % 8 == 0) ? (bx % 8) * (G / 8) + bx / 8 : bx;
    unsigned char* ws = args.ws;
    const float* x = args.in[0]; const float* g_ffn1 = args.in[1]; const float* w_in1 = args.in[2]; const float* w_out1 = args.in[3];
    const float* g_mix = args.in[4]; const float* w_mix = args.in[5]; const float* b_gate = args.in[6]; const float* rel_a = args.in[7];
    const float* lq1 = args.in[8]; const float* lk1 = args.in[9]; const float* lq2 = args.in[10]; const float* lk2 = args.in[11];
    const float* subg = args.in[12]; const float* t5 = args.in[13]; const float* w_a = args.in[14]; const float* w_b = args.in[15];
    const float* w_o = args.in[16]; const float* g_ffn2 = args.in[17]; const float* w_in2 = args.in[18]; const float* w_out2 = args.in[19]; const float* g_fin = args.in[20];
    float* out = args.out;
    float* SSQ0 = (float*)(ws + WS_SSQ0); float* SSQ1 = (float*)(ws + WS_SSQ1); float* SSQ2 = (float*)(ws + WS_SSQ2); float* SSQ3 = (float*)(ws + WS_SSQ3);
    bf16_t* WIN1 = (bf16_t*)(ws + WS_WIN1); bf16_t* WOUT1 = (bf16_t*)(ws + WS_WOUT1); bf16_t* WMIX = (bf16_t*)(ws + WS_WMIX); bf16_t* WA = (bf16_t*)(ws + WS_WA);
    bf16_t* WB = (bf16_t*)(ws + WS_WB); bf16_t* WO = (bf16_t*)(ws + WS_WO); bf16_t* WIN2 = (bf16_t*)(ws + WS_WIN2); bf16_t* WOUT2 = (bf16_t*)(ws + WS_WOUT2);
    bf16_t* XB = (bf16_t*)(ws + WS_XB); bf16_t* HB = (bf16_t*)(ws + WS_H);
    bf16_t* QQ = (bf16_t*)(ws + WS_QQ); bf16_t* KA = (bf16_t*)(ws + WS_KA); bf16_t* VA = (bf16_t*)(ws + WS_VA); bf16_t* KB = (bf16_t*)(ws + WS_KB); bf16_t* VB = (bf16_t*)(ws + WS_VB);
    bf16_t* GA = (bf16_t*)(ws + WS_GA); bf16_t* GB = (bf16_t*)(ws + WS_GB); bf16_t* MG = (bf16_t*)(ws + WS_MG);

    for (int u = tid; u < (LDS_BYTES - LDSCTL_OFF) / 4; u += NWAVES * 64) ((LAS unsigned*)(lds + LDSCTL_OFF))[u] = 0u;
    __syncthreads();
    const int lo = args.ph_lo, hi = args.ph_hi;
    const bool one_launch = (hi - lo) > 1;
    XcdBarrier bar; bar.bar = (unsigned*)(ws + WS_CTL) + CW_BAR; bar.x = 0; bar.st = nullptr;
    if (one_launch) bar = xcd_barrier_post((unsigned*)(ws + WS_CTL) + CW_BAR, MISC + 8);
#define IN(k) (lo <= (k) && (k) < hi)
#define SEAM(k) do { if (IN(k) && IN((k) + 1)) { xcd_barrier(bar); } } while (0)

    if (IN(0)) for (int rep_ = 0; rep_ < (PROBE_DUP == 0 ? 2 : 1); ++rep_) {
        LAS float* scr = (LAS float*)(lds + wave * 16384);
        const int gw = vcu * NWAVES + wave, NGW = G * NWAVES;
        constexpr int I_IN = (DM / 64) * (NFF / 32), I_OUT = (DFF / 64) * (DM / 32), I_MIX = (DM / 64) * (NMIX / 32), I_BR = (512 / 64) * (DM / 32), I_O = (DM / 64) * (DM / 32);
        constexpr int NITEMS = 2 * I_IN + 2 * I_OUT + I_MIX + 2 * I_BR + I_O;
        for (int it = gw; it < NITEMS; it += NGW) {
            int r = it;
            if (r < I_IN) { p0_transpose_item<true, true>(w_in1, DM, NFF, g_ffn1, WIN1, scr, r, lane); continue; } r -= I_IN;
            if (r < I_IN) { p0_transpose_item<true, true>(w_in2, DM, NFF, g_ffn2, WIN2, scr, r, lane); continue; } r -= I_IN;
            if (r < I_OUT) { p0_transpose_item<false, false>(w_out1, DFF, DM, nullptr, WOUT1, scr, r, lane); continue; } r -= I_OUT;
            if (r < I_OUT) { p0_transpose_item<false, false>(w_out2, DFF, DM, nullptr, WOUT2, scr, r, lane); continue; } r -= I_OUT;
            if (r < I_MIX) { p0_transpose_item<false, true>(w_mix, DM, NMIX, g_mix, WMIX, scr, r, lane); continue; } r -= I_MIX;
            if (r < I_BR) { p0_transpose_item<false, false>(w_a, 512, DM, nullptr, WA, scr, r, lane); continue; } r -= I_BR;
            if (r < I_BR) { p0_transpose_item<false, false>(w_b, 512, DM, nullptr, WB, scr, r, lane); continue; } r -= I_BR;
            p0_transpose_item<false, false>(w_o, DM, DM, nullptr, WO, scr, r, lane);
        }
        for (int m = gw; m < M; m += NGW) {
            const GAS f32x4* xr = (const GAS f32x4*)(x + (size_t)m * DM) + lane;
            f32x4 v[4]; float s = 0.f;
#pragma unroll
            for (int j = 0; j < 4; ++j) { v[j] = xr[64 * j]; s += (v[j].x * v[j].x + v[j].y * v[j].y) + (v[j].z * v[j].z + v[j].w * v[j].w); }
            s = wave_sum(s);
            GAS u32x2* o8 = (GAS u32x2*)(XB + (size_t)m * DM) + lane;
#pragma unroll
            for (int j = 0; j < 4; ++j) { u32x2 wv; wv.x = cvt_pk_bf16(v[j].x, v[j].y); wv.y = cvt_pk_bf16(v[j].z, v[j].w); o8[64 * j] = wv; }
            if (lane < 16) SSQ0[(size_t)m * 16 + lane] = lane == 0 ? s : 0.f;
        }
    }
    SEAM(0);
    if (IN(1)) {
        pg8::Gemm g{DM, DM, DM}; pg8::StaticOrder S{XB, WIN1, DM, DM, M / 256, NFF / 256, G, bx};
        pg8::EpiSwiglu E{HB, SSQ0};
        pg8::gemm_phase(lds, g, S, E);
        if (PROBE_DUP == 1) { __syncthreads(); pg8::gemm_phase(lds, g, S, E); }
    }
    SEAM(1);
    if (PROBE_DUP == 100 && one_launch) { for (int i_ = 0; i_ < 8; ++i_) xcd_barrier(bar); }
    if (PROBE_DUP == 101 && one_launch) { cg::this_grid().sync(); cg::this_grid().sync(); }
    if (IN(2)) {
        pg8::Gemm g{DFF, DFF, DFF}; pg8::StaticOrder S{HB, WOUT1, DFF, DFF, M / 256, DM / 256, G, bx};
        pg8::EpiResid<false> E{x, nullptr, XB, SSQ1, 0.5f};
        pg8::gemm_phase(lds, g, S, E);
        if (PROBE_DUP == 2) { __syncthreads(); pg8::gemm_phase(lds, g, S, E); }
    }
    SEAM(2);
    if (IN(3)) {
        pg8::Gemm g{DM, DM, DM}; pg8::StaticOrder S{XB, WMIX, DM, DM, M / 256, NMIX / 256, G, bx};
        pg8::EpiMix E{QQ, KA, VA, KB, VB, GA, GB, SSQ1, b_gate};
        pg8::gemm_phase(lds, g, S, E);
        if (PROBE_DUP == 3) { __syncthreads(); pg8::gemm_phase(lds, g, S, E); }
    }
    SEAM(3);
    if (IN(4)) {
        att::Params P{QQ, KA, VA, KB, VB, QQ, rel_a, t5, lq1, lk1, lq2, lk2, subg};
        if (PROBE_DUP >= 40 && PROBE_DUP < 80) {
            constexpr int PR = (PROBE_DUP >= 40 && PROBE_DUP < 80) ? (PROBE_DUP - 40) & 7 : 0; constexpr int WHICH = (PROBE_DUP >= 40 && PROBE_DUP < 80) ? (PROBE_DUP - 40) >> 3 : 0;
            att::Params P2{QQ, KA, VA, KB, VB, XB, rel_a, t5, lq1, lk1, lq2, lk2, subg};
            for (int v = vcu; v < 256; v += G) {
                const int bh = v >> 3, j = v & 7, b = bh >> 2, hp = bh & 3;
                if (WHICH != 2) { att::unit<1, PR>((LAS char*)lds, P2, b, hp, 15 - j); att::unit<1, PR>((LAS char*)lds, P2, b, hp, j); }
                if (WHICH != 1) { att::unit<0, PR>((LAS char*)lds, P2, b, hp, 15 - j); att::unit<0, PR>((LAS char*)lds, P2, b, hp, j); }
            }
            __syncthreads();
        }
        for (int v = vcu; v < 256; v += G) {
            const int bh = v >> 3, j = v & 7, b = bh >> 2, hp = bh & 3;
            att::unit<1>((LAS char*)lds, P, b, hp, 15 - j);
            att::unit<0>((LAS char*)lds, P, b, hp, 15 - j);
            att::unit<1>((LAS char*)lds, P, b, hp, j);
            att::unit<0>((LAS char*)lds, P, b, hp, j);
        }
    }
    SEAM(4);
    if (IN(5)) {
        pg8::Gemm g{DM, 512, 512}; pg8::BranchOrder S{QQ, QQ + 512, WA, WB, DM, 512, M / 256, DM / 256, G, bx};
        pg8::EpiBranch E{GA, GB, MG};
        pg8::gemm_phase(lds, g, S, E);
        if (PROBE_DUP == 5) { __syncthreads(); pg8::gemm_phase(lds, g, S, E); }
    }
    SEAM(5);
    if (IN(6)) {
        pg8::Gemm g{DM, DM, DM}; pg8::StaticOrder S{MG, WO, DM, DM, M / 256, DM / 256, G, bx};
        pg8::EpiResid<true> E{XB, nullptr, XB, SSQ2, 1.0f};
        pg8::gemm_phase(lds, g, S, E);
    }
    SEAM(6);
    if (IN(7)) {
        pg8::Gemm g{DM, DM, DM}; pg8::StaticOrder S{XB, WIN2, DM, DM, M / 256, NFF / 256, G, bx};
        pg8::EpiSwiglu E{HB, SSQ2};
        pg8::gemm_phase(lds, g, S, E);
    }
    SEAM(7);
    if (IN(8)) {
        pg8::Gemm g{DFF, DFF, DFF}; pg8::StaticOrder S{HB, WOUT2, DFF, DFF, M / 256, DM / 256, G, bx};
        pg8::EpiResid<true> E{XB, out, nullptr, SSQ3, 0.5f};
        pg8::gemm_phase(lds, g, S, E);
    }
    SEAM(8);
    if (IN(9)) {
        const int gw = vcu * NWAVES + wave, NGW = G * NWAVES;
        f32x4 gv[4];
#pragma unroll
        for (int j = 0; j < 4; ++j) gv[j] = ((const f32x4*)g_fin)[lane + 64 * j];
        if (PROBE_DUP == 9) for (int m = gw; m < M; m += NGW) {
            const float rs = row_rstd(SSQ3, m);
            const f32x4* xr = (const f32x4*)(out + (size_t)m * DM) + lane; f32x4* xo = (f32x4*)(ws + WS_XB + (size_t)m * DM * 4) + lane;
#pragma unroll
            for (int j = 0; j < 4; ++j) { const f32x4 v = xr[64 * j]; xo[64 * j] = v * rs * gv[j]; }
        }
        for (int m = gw; m < M; m += NGW) {
            const float rs = row_rstd(SSQ3, m);
            f32x4* xr = (f32x4*)(out + (size_t)m * DM) + lane;
#pragma unroll
            for (int j = 0; j < 4; ++j) { const f32x4 v = xr[64 * j]; xr[64 * j] = v * rs * gv[j]; }
        }
    }
#undef IN
#undef SEAM
}

extern "C" void kernel_launch(void* const* d_in, const int* in_sizes, int n_in, void* d_out, int out_size, void* d_ws, size_t ws_size, hipStream_t stream) {
    static int grid = 0;
    if (grid == 0) {
        if (n_in != 21 || in_sizes[0] != M * DM || out_size != M * DM || ws_size < WS_END) { fprintf(stderr, "kernel_launch: unexpected shapes (n_in %d, in0 %d, out %d, ws %zu); nothing launched\n", n_in, n_in > 0 ? in_sizes[0] : -1, out_size, ws_size); grid = -1; return; }
        int dev = 0, cus = 0, per_cu = 0;
        if (hipGetDevice(&dev) != hipSuccess || hipDeviceGetAttribute(&cus, hipDeviceAttributeMultiprocessorCount, dev) != hipSuccess) { fprintf(stderr, "kernel_launch: device query failed\n"); grid = -1; return; }
        if (hipFuncSetAttribute((const void*)fwd_kernel, hipFuncAttributeMaxDynamicSharedMemorySize, LDS_BYTES) != hipSuccess) { fprintf(stderr, "kernel_launch: hipFuncSetAttribute failed\n"); grid = -1; return; }
        if (hipOccupancyMaxActiveBlocksPerMultiprocessor(&per_cu, (const void*)fwd_kernel, NWAVES * 64, LDS_BYTES) != hipSuccess || per_cu < 1) { fprintf(stderr, "kernel_launch: occupancy query says %d blocks per CU\n", per_cu); per_cu = 1; }
        (void)hipGetLastError();
        grid = cus;
    }
    if (grid < 0) return;
    if (hipMemsetAsync((char*)d_ws + WS_CTL, 0, CTL_ZERO_BYTES, stream) != hipSuccess) { fprintf(stderr, "kernel_launch: hipMemsetAsync failed\n"); return; }
    Args a{};
    for (int i = 0; i < 21; ++i) a.in[i] = (const float*)d_in[i];
    a.out = (float*)d_out; a.ws = (unsigned char*)d_ws;
#if MK_N_LAUNCHES == 1
    a.ph_lo = 0; a.ph_hi = N_PHASES;
    void* kargs[] = {&a};
    hipError_t e = hipLaunchCooperativeKernel((const void*)fwd_kernel, dim3(grid), dim3(NWAVES * 64), kargs, LDS_BYTES, stream);
    if (e != hipSuccess) fprintf(stderr, "kernel_launch: cooperative launch failed: %s (grid %d)\n", hipGetErrorString(e), grid);
#else
    for (int p = 0; p < N_PHASES; ++p) {
        a.ph_lo = p; a.ph_hi = p + 1;
        hipLaunchKernelGGL(fwd_kernel, dim3(grid), dim3(NWAVES * 64), LDS_BYTES, stream, a);
    }
#endif
}
```

```cpp
#include <hip/hip_runtime.h>
#include <hip/hip_cooperative_groups.h>
#include <cstdio>
#include <cstdint>
namespace cg = cooperative_groups;

#ifndef MK_N_LAUNCHES
#define MK_N_LAUNCHES 1
#endif

#ifndef MK_PLAIN_LAUNCH
#define MK_PLAIN_LAUNCH 0
#endif
#ifndef PROBE_DUP
#define PROBE_DUP -1
#endif
#define LAS __attribute__((address_space(3)))
#define GAS __attribute__((address_space(1)))
typedef unsigned short bf16_t;
typedef short bf16x8 __attribute__((ext_vector_type(8)));
typedef short s16x4 __attribute__((ext_vector_type(4)));
typedef float f32x4 __attribute__((ext_vector_type(4)));
typedef float f32x16 __attribute__((ext_vector_type(16)));
typedef float f32x2 __attribute__((ext_vector_type(2)));
typedef unsigned u32x4 __attribute__((ext_vector_type(4)));
typedef unsigned u32x2 __attribute__((ext_vector_type(2)));
typedef __bf16 bf16x2_t __attribute__((ext_vector_type(2)));

constexpr int BATCH = 8, SEQ = 2048, DM = 1024, M = BATCH * SEQ;
constexpr int DFF = 2816, NFF = 2 * DFF, NMIX = 5120;
constexpr float EPS = 1e-6f;
constexpr float LOG2E = 1.4426950408889634f;
constexpr float QSCALE = 0.125f * LOG2E;
constexpr int NWAVES = 8;

constexpr size_t MiB = 1u << 20;
constexpr size_t WS_CTL = 0, CTL_ZERO_BYTES = 64 * 1024;
constexpr size_t WS_SSQ0 = 1 * MiB, WS_SSQ1 = 2 * MiB, WS_SSQ2 = 3 * MiB, WS_SSQ3 = 4 * MiB;
constexpr size_t WS_WIN1 = 5 * MiB, WS_WOUT1 = 16 * MiB, WS_WMIX = 22 * MiB, WS_WA = 32 * MiB, WS_WB = 33 * MiB, WS_WO = 34 * MiB, WS_WIN2 = 36 * MiB, WS_WOUT2 = 47 * MiB;
constexpr size_t WS_XB = 53 * MiB;
constexpr size_t WS_R = 85 * MiB;
constexpr size_t WS_H = WS_R;
constexpr size_t WS_QQ = WS_R, WS_KA = WS_R + 32 * MiB, WS_VA = WS_R + 48 * MiB, WS_KB = WS_R + 64 * MiB, WS_VB = WS_R + 80 * MiB, WS_GA = WS_R + 96 * MiB, WS_GB = WS_R + 128 * MiB;
constexpr size_t WS_MG = WS_KA;
constexpr size_t WS_END = WS_R + 160 * MiB;
static_assert(WS_END <= 256 * MiB, "d_ws map");
static_assert(WS_WOUT2 + (size_t)DM * DFF * 2 <= WS_XB && WS_XB + (size_t)M * DM * 2 <= WS_R && WS_H + (size_t)M * DFF * 2 <= WS_END, "d_ws map");
constexpr int CW_BAR = 1024;

constexpr int RING_BYTES = 131072;
constexpr int LDSCTL_OFF = RING_BYTES, MISC_OFF = LDSCTL_OFF + 320, RTAB_OFF = LDSCTL_OFF + 1024;
constexpr int LDS_BYTES = 147456;

__device__ __forceinline__ unsigned cvt_pk_bf16(float lo, float hi) { f32x2 v = {lo, hi}; bf16x2_t b = __builtin_convertvector(v, bf16x2_t); return __builtin_bit_cast(unsigned, b); }
__device__ __forceinline__ float bf16lo(unsigned w) { return __uint_as_float(w << 16); }
__device__ __forceinline__ float bf16hi(unsigned w) { return __uint_as_float(w & 0xffff0000u); }
__device__ __forceinline__ float fast_rcp(float x) { return __builtin_amdgcn_rcpf(x); }
__device__ __forceinline__ float fast_exp2(float x) { return __builtin_amdgcn_exp2f(x); }
__device__ __forceinline__ float sigmoidf_(float v) { return fast_rcp(1.0f + fast_exp2(-v * LOG2E)); }
__device__ __forceinline__ float wave_sum(float v) {
#pragma unroll
    for (int o = 1; o < 64; o <<= 1) v += __shfl_xor(v, o);
    return v;
}
__device__ __forceinline__ float rstd_of(const f32x4 a) { return __builtin_amdgcn_rsqf(((a.x + a.y) + (a.z + a.w)) * (1.0f / DM) + EPS); }
__device__ __forceinline__ float row_rstd(const float* ssq, int row) { return rstd_of(*(const f32x4*)(ssq + (size_t)row * 4)); }

namespace pg8 {
constexpr int BM = 256, BK = 64, HALF = 128, HTB = HALF * BK * 2, STAGE_BYTES = 8 * HTB, NXCD = 8, WGM = 8, MAXU = 8;
__host__ __device__ __forceinline__ int lds_byte(int r, int c) { const int st = (r >> 4) * 2 + (c >> 5), rr = r & 15, cc = c & 31, ob = rr * 64 + cc * 2; return st * 1024 + (ob ^ (((ob >> 9) & 1) << 5)); }
__host__ __device__ __forceinline__ void stage_rc(int b, int& R, int& C) { const int st = b / 1024, sb = b % 1024, swz = sb ^ (((sb >> 9) & 1) << 5); R = (st >> 1) * 16 + swz / 64; C = (st & 1) * 32 + (swz % 64) / 2; }
__host__ __device__ __forceinline__ int perm32(int rho) { const int n = rho >> 4, i = rho & 15; return 8 * (i >> 2) + 4 * n + (i & 3); }

struct Unit { int pm, pn, aux; };
struct Gemm { int lda, ldb, K; };

__device__ __forceinline__ void tile_of(int L, int nM, int nN, int& pm, int& pn) {
    const int nwg = nM * nN; int wgid = L;
    { const int q = nwg / NXCD, r = nwg % NXCD, xcd = wgid % NXCD, off = wgid / NXCD; wgid = (xcd < r ? xcd * (q + 1) : r * (q + 1) + (xcd - r) * q) + off; }
    const int nig = WGM * nN, gid = wgid / nig, fm = gid * WGM, gsz = (nM - fm) < WGM ? (nM - fm) : WGM;
    pm = fm + ((wgid % nig) % gsz); pn = (wgid % nig) / gsz;
}
struct StaticOrder {
    const bf16_t* A; const bf16_t* Bt; int lda, ldb, nM, nN, G, c;
    __device__ __forceinline__ bool next(int i, Unit& u) const { const long L = (long)i * G + c; if (L >= (long)nM * nN) return false; tile_of((int)L, nM, nN, u.pm, u.pn); u.aux = 0; return true; }
    __device__ __forceinline__ const char* aptr(const Unit& u) const { return (const char*)(A + (size_t)u.pm * BM * lda); }
    __device__ __forceinline__ const char* bptr(const Unit& u) const { return (const char*)(Bt + (size_t)u.pn * BM * ldb); }
};
struct OneUnit {
    StaticOrder S; int i0;
    __device__ __forceinline__ bool next(int i, Unit& u) const { return i == 0 ? S.next(i0, u) : false; }
    __device__ __forceinline__ const char* aptr(const Unit& u) const { return S.aptr(u); }
    __device__ __forceinline__ const char* bptr(const Unit& u) const { return S.bptr(u); }
};
struct BranchOrder {
    const bf16_t *A0, *A1, *B0, *B1; int lda, ldb, nM, nN, G, c;
    __device__ __forceinline__ bool next(int i, Unit& u) const { const long L = (long)(i >> 1) * G + c; if (L >= (long)nM * nN) return false; tile_of((int)L, nM, nN, u.pm, u.pn); u.aux = i & 1; return true; }
    __device__ __forceinline__ const char* aptr(const Unit& u) const { return (const char*)((u.aux ? A1 : A0) + (size_t)u.pm * BM * lda); }
    __device__ __forceinline__ const char* bptr(const Unit& u) const { return (const char*)((u.aux ? B1 : B0) + (size_t)u.pn * BM * ldb); }
};

typedef f32x4 Acc[2][2][4][2];

struct EpiSwiglu {
    static constexpr bool PERM = true, ROWPRE = true, AFTER_DRAIN = false;
    bf16_t* H; const float* ssq;
    __device__ __forceinline__ bool keep(const Unit&) const { return false; }
    __device__ __forceinline__ void operator()(Acc& acc, const Unit& u, int wr, int wc, int fr, int fq, const LAS float* rtab, LAS unsigned char*) const {
#pragma unroll
        for (int ai = 0; ai < 2; ++ai)
#pragma unroll
            for (int m = 0; m < 4; ++m) {
                const int row = u.pm * BM + ai * HALF + wr * 64 + m * 16 + fr; const float rs = rtab[ai * HALF + wr * 64 + m * 16 + fr];
                float h[8];
#pragma unroll
                for (int n = 0; n < 2; ++n)
#pragma unroll
                    for (int e = 0; e < 4; ++e) { const float g = acc[ai][0][m][n][e] * rs, up = acc[ai][1][m][n][e] * rs; h[n * 4 + e] = g * sigmoidf_(g) * up; }
                u32x4 w; w.x = cvt_pk_bf16(h[0], h[1]); w.y = cvt_pk_bf16(h[2], h[3]); w.z = cvt_pk_bf16(h[4], h[5]); w.w = cvt_pk_bf16(h[6], h[7]);
                *(u32x4*)(H + (size_t)row * DFF + u.pn * HALF + wc * 32 + 8 * fq) = w;
            }
    }
};
template <bool BF>
struct EpiResid {
    static constexpr bool PERM = false, ROWPRE = false, AFTER_DRAIN = true;
    const void* base; float* out; bf16_t* xb; float* ssq; float alpha;
    __device__ __forceinline__ bool keep(const Unit&) const { return false; }
    __device__ __forceinline__ void operator()(Acc& acc, const Unit& u, int wr, int wc, int fr, int fq, const LAS float*, LAS unsigned char* lds) const {
        LAS float* PS = (LAS float*)lds;
        const int col0 = u.pn * BM + wc * 32 + 4 * fq;
#pragma unroll
        for (int ai = 0; ai < 2; ++ai)
#pragma unroll
            for (int m = 0; m < 4; ++m) {
                const int row = u.pm * BM + ai * HALF + wr * 64 + m * 16 + fr; const size_t off = (size_t)row * DM + col0; float s = 0.f;
#pragma unroll
                for (int bj = 0; bj < 2; ++bj)
#pragma unroll
                    for (int n = 0; n < 2; ++n) {
                        f32x4 bs;
                        if (BF) { const u32x2 t = *(const u32x2*)((const bf16_t*)base + off + bj * HALF + n * 16); bs = (f32x4){bf16lo(t.x), bf16hi(t.x), bf16lo(t.y), bf16hi(t.y)}; }
                        else bs = *(const f32x4*)((const float*)base + off + bj * HALF + n * 16);
                        const f32x4 v = bs + acc[ai][bj][m][n] * alpha;
                        if (out) *(f32x4*)(out + off + bj * HALF + n * 16) = v;
                        s += (v.x * v.x + v.y * v.y) + (v.z * v.z + v.w * v.w);
                        if (xb) { u32x2 w; w.x = cvt_pk_bf16(v.x, v.y); w.y = cvt_pk_bf16(v.z, v.w); *(u32x2*)(xb + off + bj * HALF + n * 16) = w; }
                    }
                s += __shfl_xor(s, 16); s += __shfl_xor(s, 32);
                if (fq == 0) PS[(ai * HALF + wr * 64 + m * 16 + fr) * 4 + wc] = s;
            }
        __syncthreads();
        if (threadIdx.x < 256) { const f32x4 p = *(const LAS f32x4*)(PS + threadIdx.x * 4); ssq[(size_t)(u.pm * BM + threadIdx.x) * 4 + u.pn] = (p.x + p.y) + (p.z + p.w); }
        __syncthreads();
    }
};
struct EpiNull {
    static constexpr bool PERM = true, ROWPRE = false, AFTER_DRAIN = false;
    bf16_t* H; const float* ssq;
    __device__ __forceinline__ bool keep(const Unit&) const { return false; }
    __device__ __forceinline__ void operator()(Acc& acc, const Unit& u, int wr, int wc, int fr, int fq, const LAS float*, LAS unsigned char*) const {
        float s = 0.f;
#pragma unroll
        for (int ai = 0; ai < 2; ++ai)
#pragma unroll
            for (int bj = 0; bj < 2; ++bj)
#pragma unroll
                for (int m = 0; m < 4; ++m)
#pragma unroll
                    for (int n = 0; n < 2; ++n) s += (acc[ai][bj][m][n].x + acc[ai][bj][m][n].y) + (acc[ai][bj][m][n].z + acc[ai][bj][m][n].w);
        if (s == 1.2345e30f) H[0] = 1;
    }
};
struct EpiMix {
    static constexpr bool PERM = true, ROWPRE = true, AFTER_DRAIN = false;
    bf16_t *QQ, *KA, *VA, *KB, *VB, *GA, *GB; const float* ssq; const float* bgate;
    __device__ __forceinline__ bool keep(const Unit&) const { return false; }
    __device__ __forceinline__ void operator()(Acc& acc, const Unit& u, int wr, int wc, int fr, int fq, const LAS float* rtab, LAS unsigned char*) const {
        const int pn = u.pn; bf16_t* dst; int ld; float sc = 1.f; bool gate = false; int gcol = 0;
        if (pn < 2) { dst = QQ + pn * 256; ld = 1024; sc = QSCALE; }
        else if (pn < 4) { dst = KA + (pn - 2) * 256; ld = 512; }
        else if (pn < 6) { dst = VA + (pn - 4) * 256; ld = 512; }
        else if (pn < 8) { dst = QQ + 512 + (pn - 6) * 256; ld = 1024; sc = QSCALE; }
        else if (pn < 10) { dst = KB + (pn - 8) * 256; ld = 512; }
        else if (pn < 12) { dst = VB + (pn - 10) * 256; ld = 512; }
        else if (pn < 16) { dst = GA + (pn - 12) * 256; ld = 1024; gate = true; gcol = (pn - 12) * 256; }
        else { dst = GB + (pn - 16) * 256; ld = 1024; gate = true; gcol = (pn - 12) * 256; }
        const int cw = wc * 32 + 8 * fq;
        f32x4 bv[2][2];
#pragma unroll
        for (int bj = 0; bj < 2; ++bj)
#pragma unroll
            for (int n = 0; n < 2; ++n) bv[bj][n] = gate ? *(const f32x4*)(bgate + gcol + bj * HALF + cw + 4 * n) : (f32x4){0.f, 0.f, 0.f, 0.f};
#pragma unroll
        for (int ai = 0; ai < 2; ++ai)
#pragma unroll
            for (int m = 0; m < 4; ++m) {
                const int row = u.pm * BM + ai * HALF + wr * 64 + m * 16 + fr; const float rs = rtab[ai * HALF + wr * 64 + m * 16 + fr] * sc;
                bf16_t* rowp = dst + (size_t)row * ld + cw;
#pragma unroll
                for (int bj = 0; bj < 2; ++bj) {
                    f32x4 v0 = acc[ai][bj][m][0] * rs, v1 = acc[ai][bj][m][1] * rs;
                    if (gate) {
                        v0 = v0 + bv[bj][0]; v1 = v1 + bv[bj][1];
                        v0 = (f32x4){sigmoidf_(v0.x), sigmoidf_(v0.y), sigmoidf_(v0.z), sigmoidf_(v0.w)}; v1 = (f32x4){sigmoidf_(v1.x), sigmoidf_(v1.y), sigmoidf_(v1.z), sigmoidf_(v1.w)};
                    }
                    u32x4 w; w.x = cvt_pk_bf16(v0.x, v0.y); w.y = cvt_pk_bf16(v0.z, v0.w); w.z = cvt_pk_bf16(v1.x, v1.y); w.w = cvt_pk_bf16(v1.z, v1.w);
                    *(u32x4*)(rowp + bj * HALF) = w;
                }
            }
    }
};
struct EpiBranch {
    static constexpr bool PERM = true, ROWPRE = false, AFTER_DRAIN = false;
    const bf16_t *GA, *GB; bf16_t* MG; const float* ssq;
    __device__ __forceinline__ bool keep(const Unit& u) const { return u.aux == 0; }
    __device__ __forceinline__ void operator()(Acc& acc, const Unit& u, int wr, int wc, int fr, int fq, const LAS float*, LAS unsigned char*) const {
        const int col0 = u.pn * BM + wc * 32 + 8 * fq;
#pragma unroll
        for (int ai = 0; ai < 2; ++ai)
#pragma unroll
            for (int m = 0; m < 4; ++m) {
                const int row = u.pm * BM + ai * HALF + wr * 64 + m * 16 + fr; const size_t off = (size_t)row * DM + col0;
#pragma unroll
                for (int bj = 0; bj < 2; ++bj) {
                    const u32x4 gb = *(const u32x4*)(GB + off + bj * HALF);
                    float b[8] = {bf16lo(gb.x), bf16hi(gb.x), bf16lo(gb.y), bf16hi(gb.y), bf16lo(gb.z), bf16hi(gb.z), bf16lo(gb.w), bf16hi(gb.w)};
#pragma unroll
                    for (int e = 0; e < 8; ++e) b[e] = fmaxf(b[e], 1e-30f);
                    if (u.aux == 0) {
                        const u32x4 ga = *(const u32x4*)(GA + off + bj * HALF);
                        const float a[8] = {bf16lo(ga.x), bf16hi(ga.x), bf16lo(ga.y), bf16hi(ga.y), bf16lo(ga.z), bf16hi(ga.z), bf16lo(ga.w), bf16hi(ga.w)};
#pragma unroll
                        for (int e = 0; e < 8; ++e) acc[ai][bj][m][e >> 2][e & 3] *= a[e] / b[e];
                    } else {
                        float v[8];
#pragma unroll
                        for (int e = 0; e < 8; ++e) v[e] = acc[ai][bj][m][e >> 2][e & 3] * b[e];
                        u32x4 w; w.x = cvt_pk_bf16(v[0], v[1]); w.y = cvt_pk_bf16(v[2], v[3]); w.z = cvt_pk_bf16(v[4], v[5]); w.w = cvt_pk_bf16(v[6], v[7]);
                        *(u32x4*)(MG + off + bj * HALF) = w;
                    }
                }
            }
    }
};

template <class Epi, class Sched>
__device__ __forceinline__ void gemm_phase(LAS unsigned char* lds, const Gemm g, const Sched& S, const Epi& E) {
    LAS float* rtab = (LAS float*)(lds + RTAB_OFF);
    const int tid = threadIdx.x, wid = __builtin_amdgcn_readfirstlane(tid >> 6), lane = tid & 63, wr = wid >> 2, wc = wid & 3, fr = lane & 15, fq = lane >> 4;
    const int K = g.K, nt = K / BK;
    unsigned voffA[2], voffB[2];
#pragma unroll
    for (int i = 0; i < 2; ++i) { int R, C; stage_rc(tid * 16 + i * 8192, R, C); const int Rb = Epi::PERM ? ((R & ~31) + perm32(R & 31)) : R;
        voffA[i] = (unsigned)(R * g.lda + C) * 2u; voffB[i] = (unsigned)(Rb * g.ldb + C) * 2u; }
    const size_t kstep = (size_t)(BK * 2);
    const size_t hstepA = (size_t)HALF * g.lda * 2, hstepB = (size_t)HALF * g.ldb * 2;
    const unsigned ldsw = (unsigned)wid * 1024u;
    const int aoff = lds_byte(wr * 64 + fr, fq * 8), boff = lds_byte(wc * 32 + fr, fq * 8);
#define PG8_SA(b, h) (((b) * 2 + (h)) * HTB)
#define PG8_SB(b, h) ((4 + (b) * 2 + (h)) * HTB)
#define PG8_STAGE(bufoff, gbase, voff) do { _Pragma("unroll") for (int _i = 0; _i < 2; ++_i) \
        __builtin_amdgcn_global_load_lds((const unsigned*)((const char*)(gbase) + (voff)[_i]), (LAS unsigned*)(lds + (bufoff) + ldsw + _i * 8192), 16, 0, 0); } while (0)
#define PG8_LDA(dst, b, h) do { _Pragma("unroll") for (int m = 0; m < 4; ++m) _Pragma("unroll") for (int k = 0; k < 2; ++k) dst[m][k] = *(const LAS bf16x8*)(lds + PG8_SA(b, h) + aoff + m * 2048 + k * 1024); } while (0)
#define PG8_LDB(dst, b, h) do { _Pragma("unroll") for (int n = 0; n < 2; ++n) _Pragma("unroll") for (int k = 0; k < 2; ++k) dst[n][k] = *(const LAS bf16x8*)(lds + PG8_SB(b, h) + boff + n * 2048 + k * 1024); } while (0)
#define PG8_MMA(ai, bj, At, Bt) do { __builtin_amdgcn_s_setprio(1); _Pragma("unroll") for (int m = 0; m < 4; ++m) _Pragma("unroll") for (int n = 0; n < 2; ++n) _Pragma("unroll") for (int k = 0; k < 2; ++k) \
        acc[ai][bj][m][n] = __builtin_amdgcn_mfma_f32_16x16x32_bf16(Bt[n][k], At[m][k], acc[ai][bj][m][n], 0, 0, 0); __builtin_amdgcn_s_setprio(0); } while (0)
#define PG8_WAIT_V(n) asm volatile("s_waitcnt vmcnt(" #n ")" ::: "memory")
#define PG8_WAIT_L(n) asm volatile("s_waitcnt lgkmcnt(" #n ")" ::: "memory")
#define PG8_BAR __builtin_amdgcn_s_barrier()
#define PG8_SCHED __builtin_amdgcn_sched_barrier(0)
    Unit cur, nxt; int ui = 0;
    if (!S.next(0, cur)) return;
    if (Epi::ROWPRE) {
        for (int i = 0; i < MAXU; ++i) { Unit uu; if (!S.next(i, uu)) break; if (tid < 256) rtab[i * 256 + tid] = rstd_of(*(const f32x4*)(E.ssq + ((size_t)uu.pm * BM + tid) * 4)); }
    }
    Acc acc;
#pragma unroll
    for (int a = 0; a < 2; ++a)
#pragma unroll
        for (int b = 0; b < 2; ++b)
#pragma unroll
            for (int m = 0; m < 4; ++m)
#pragma unroll
                for (int n = 0; n < 2; ++n) acc[a][b][m][n] = (f32x4){0.f, 0.f, 0.f, 0.f};
    bf16x8 At[4][2], B0[2][2], B1[2][2];
    const char* cA = S.aptr(cur); const char* cB = S.bptr(cur);
    PG8_STAGE(PG8_SB(0, 0), cB, voffB); PG8_STAGE(PG8_SB(0, 1), cB + hstepB, voffB); PG8_STAGE(PG8_SA(0, 0), cA, voffA); PG8_STAGE(PG8_SA(0, 1), cA + hstepA, voffA);
    if (wr == 1) PG8_BAR;
    PG8_WAIT_V(2); PG8_BAR;
    PG8_STAGE(PG8_SB(1, 0), cB + kstep, voffB); PG8_STAGE(PG8_SA(1, 0), cA + kstep, voffA); PG8_STAGE(PG8_SB(1, 1), cB + hstepB + kstep, voffB);
    PG8_WAIT_V(6); PG8_BAR;
    for (;;) {
        const bool has_next = S.next(ui + 1, nxt);
        const char* nA = has_next ? S.aptr(nxt) : cA; const char* nB = has_next ? S.bptr(nxt) : cB;
        for (int t = 0; t < nt; t += 2) {
            const bool last = (t == nt - 2);
            const char* a1 = cA + (size_t)(t + 1) * kstep;
            const char* a2 = last ? nA : cA + (size_t)(t + 2) * kstep; const char* b2 = last ? nB : cB + (size_t)(t + 2) * kstep;
            const char* a3 = a2 + kstep; const char* b3 = b2 + kstep;
            PG8_LDB(B0, 0, 0); PG8_LDB(B1, 0, 1); PG8_SCHED; PG8_LDA(At, 0, 0); PG8_STAGE(PG8_SA(1, 1), a1 + hstepA, voffA);
            PG8_WAIT_V(8); PG8_WAIT_L(0); PG8_BAR; PG8_MMA(0, 0, At, B0); PG8_MMA(0, 1, At, B1); PG8_BAR; PG8_SCHED;
            PG8_LDA(At, 0, 1); PG8_STAGE(PG8_SB(0, 0), b2, voffB); PG8_STAGE(PG8_SB(0, 1), b2 + hstepB, voffB); PG8_STAGE(PG8_SA(0, 0), a2, voffA);
            PG8_WAIT_V(8); PG8_WAIT_L(0); PG8_BAR; PG8_MMA(1, 0, At, B0); PG8_MMA(1, 1, At, B1); PG8_BAR; PG8_SCHED;
            PG8_LDB(B0, 1, 0); PG8_LDB(B1, 1, 1); PG8_SCHED; PG8_LDA(At, 1, 0); PG8_STAGE(PG8_SA(0, 1), a2 + hstepA, voffA);
            PG8_WAIT_V(8); PG8_WAIT_L(0); PG8_BAR; PG8_MMA(0, 0, At, B0); PG8_MMA(0, 1, At, B1); PG8_BAR; PG8_SCHED;
            PG8_LDA(At, 1, 1); PG8_STAGE(PG8_SB(1, 0), b3, voffB); PG8_STAGE(PG8_SB(1, 1), b3 + hstepB, voffB); PG8_STAGE(PG8_SA(1, 0), a3, voffA);
            PG8_WAIT_V(8); PG8_WAIT_L(0); PG8_BAR; PG8_MMA(1, 0, At, B0); PG8_MMA(1, 1, At, B1); PG8_BAR; PG8_SCHED;
        }
        if (wr == 0) PG8_BAR;
        if (!Epi::AFTER_DRAIN) E(acc, cur, wr, wc, fr, fq, rtab + ui * 256, lds);
        if (!has_next) break;
        if (!E.keep(cur)) {
#pragma unroll
            for (int a = 0; a < 2; ++a)
#pragma unroll
                for (int b = 0; b < 2; ++b)
#pragma unroll
                    for (int m = 0; m < 4; ++m)
#pragma unroll
                        for (int n = 0; n < 2; ++n) acc[a][b][m][n] = (f32x4){0.f, 0.f, 0.f, 0.f};
        }
        cur = nxt; cA = nA; cB = nB; ++ui;
        if (wr == 1) PG8_BAR;
    }
    PG8_WAIT_V(0);
    PG8_BAR;
    if (Epi::AFTER_DRAIN) E(acc, cur, wr, wc, fr, fq, rtab, lds);
#undef PG8_SA
#undef PG8_SB
#undef PG8_STAGE
#undef PG8_LDA
#undef PG8_LDB
#undef PG8_MMA
#undef PG8_WAIT_V
#undef PG8_WAIT_L
#undef PG8_BAR
#undef PG8_SCHED
}
}

namespace att {
constexpr int STG = 32768, L_TAB = 3 * STG, L_WSF = L_TAB + 2048, L_END = L_WSF + 2048;
static_assert(L_END <= RING_BYTES, "attention LDS");
__device__ __forceinline__ int crow(int r, int hi) { return (r & 3) + 8 * (r >> 2) + 4 * hi; }
__device__ __forceinline__ float max3f(float a, float b, float c) { float r; asm("v_max3_f32 %0, %1, %2, %3" : "=v"(r) : "v"(a), "v"(b), "v"(c)); return r; }
#define ATT_SBAR() __builtin_amdgcn_sched_barrier(0)
__device__ __forceinline__ s16x4 vtr(const LAS char* p) { return __builtin_bit_cast(s16x4, __builtin_amdgcn_ds_read_tr16_b64_v4i16((LAS s16x4*)p)); }
__device__ __forceinline__ int t5_bucket(int rel) {
    const int n = rel < 0 ? -rel : rel;
    const int large = 8 + (n >= 12) + (n >= 16) + (n >= 23) + (n >= 32) + (n >= 46) + (n >= 64) + (n >= 91);
    return (rel > 0 ? 16 : 0) + (n < 8 ? n : large);
}
struct Params {
    const bf16_t* QQ; const bf16_t *KA, *VA, *KB, *VB; bf16_t* Y;
    const float *relA, *t5, *lq1, *lk1, *lq2, *lk2, *subg;
};

template <int MODE, int PRB = 0>
__device__ __forceinline__ void unit(LAS char* lds, const Params& P, int b, int hp, int qb) {
    constexpr int NDB = MODE == 0 ? 2 : 4;
    const int tid = threadIdx.x, lane = tid & 63, r32 = lane & 31, hi = lane >> 5;
    const int w = __builtin_amdgcn_readfirstlane(tid >> 6), g = w >> 2, wq = w & 3;
    const bf16_t* Kslab = (MODE == 0 ? P.KA : P.KB) + (size_t)b * SEQ * 512 + hp * 128;
    const bf16_t* Vslab = (MODE == 0 ? P.VA : P.VB) + (size_t)b * SEQ * 512 + hp * 128;
    const int qcol = (MODE == 0 ? 0 : 512) + hp * 128;
    const int qrow0 = qb * 128 + wq * 32;
    const size_t grow0 = (size_t)b * SEQ + qrow0;
    const int cq = qrow0 >> 6;
    const int t_hi = 2 * qb + 1, t_lo = MODE == 0 ? (2 * qb - 8 > 0 ? 2 * qb - 8 : 0) : 0;
    const int w_lo = MODE == 0 ? cq - 8 : 0;
    LAS float* tab = (LAS float*)(lds + L_TAB);
    if (tid < 512) {
        const int gg = tid >> 8, idx = tid & 255, rel = idx - 191; float v;
        if (MODE == 0) { const float* tb = P.relA + (2 * hp + gg) * 257; const int rc = rel < -128 ? -128 : (rel > 128 ? 128 : rel); v = (tb[rc + 128] - tb[0]) * LOG2E; }
        else { const float* tb = P.t5 + hp * 32; v = (tb[t5_bucket(rel)] - tb[15]) * LOG2E; }
        tab[gg * 256 + idx] = v;
    }
    bf16x8 qf[4];
#pragma unroll
    for (int s = 0; s < 4; ++s) qf[s] = *(const bf16x8*)(P.QQ + (grow0 + r32) * 1024 + qcol + 64 * g + 16 * s + 8 * hi);
    const int prow = 4 * w + (lane >> 4), pj = lane & 15;
    const bf16_t* ksrc = Kslab + (size_t)prow * 512 + (pj ^ (prow & 15)) * 8;
    const bf16_t* vsrc = Vslab + (size_t)prow * 512 + (((pj >> 2) ^ (prow & 3)) * 4 + (pj & 3)) * 8;
    const unsigned lds0 = (unsigned)(unsigned long)(LAS char*)lds;
#define ATT_GLDS(gsrc, ldsdst) do { unsigned keep_; asm volatile("s_mov_b32 %0, m0\n\ts_mov_b32 m0, %2\n\ts_nop 0\n\tglobal_load_lds_dwordx4 %1, off\n\ts_mov_b32 m0, %0" \
        : "=&s"(keep_) : "v"(gsrc), "s"((unsigned)__builtin_amdgcn_readfirstlane((int)(ldsdst))) : "memory"); } while (0)
#define ATT_STAGE(t, boff) do { const size_t ro_ = (size_t)(t) * 64 * 512; \
        ATT_GLDS(ksrc + ro_, lds0 + (boff) + w * 1024); ATT_GLDS(ksrc + ro_ + 32 * 512, lds0 + (boff) + (w + 8) * 1024); \
        ATT_GLDS(vsrc + ro_, lds0 + (boff) + 16384 + w * 1024); ATT_GLDS(vsrc + ro_ + 32 * 512, lds0 + (boff) + 16384 + (w + 8) * 1024); } while (0)
    if (!(PRB & 1)) { ATT_STAGE(t_lo, 0);
    if (t_lo < t_hi) ATT_STAGE(t_lo + 1, STG); }
#pragma unroll
    for (int s = 0; s < 4; ++s) asm volatile("" : "+v"(qf[s]));
    f32x16 o[NDB];
#pragma unroll
    for (int d = 0; d < NDB; ++d) o[d] = (f32x16){};
    float mrun = 0.f, lrun = 0.f;
    const int tfirst = w_lo > t_lo ? w_lo : t_lo;
    LAS float* wsf = (LAS float*)(lds + L_WSF) + w * 64;
    int koff[4], voff[NDB];
#pragma unroll
    for (int s = 0; s < 4; ++s) koff[s] = r32 * 256 + 16 * ((8 * g + 2 * s + hi) ^ (r32 & 15));
    { const int q = (lane & 15) >> 2;
#pragma unroll
      for (int d = 0; d < NDB; ++d) voff[d] = 16384 + (4 * hi + q) * 256 + 64 * (((MODE == 0 ? 2 * g : 0) + d) ^ q) + ((lane >> 4) & 1) * 32 + (lane & 3) * 8; }
    int boff = 0, bnext = 2 * STG;
    for (int t = t_lo; t <= t_hi; ++t) {
        if (t < t_hi) asm volatile("s_waitcnt vmcnt(4)" ::: "memory"); else asm volatile("s_waitcnt vmcnt(0)" ::: "memory");
        __builtin_amdgcn_s_barrier(); asm volatile("" ::: "memory");
        if (!(PRB & 1) && t + 2 <= t_hi) ATT_STAGE(t + 2, bnext);
        if (!(PRB & 2) && t >= w_lo && t <= cq) {
            const LAS char* tb_ = lds + boff;
            bf16x8 kf[8];
#pragma unroll
            for (int i = 0; i < 8; ++i) kf[i] = *(const LAS bf16x8*)(tb_ + koff[i >> 1] + (i & 1) * 8192);
            s16x4 va[16];
#pragma unroll
            for (int i = 0; i < 8; ++i) { va[2 * i] = vtr(tb_ + voff[i >> 2] + (i & 3) * 4096); va[2 * i + 1] = vtr(tb_ + voff[i >> 2] + (i & 3) * 4096 + 2048); }
            ATT_SBAR();
            f32x16 s0 = (f32x16){}, s1 = (f32x16){};
#pragma unroll
            for (int s = 0; s < 4; ++s) {
                s0 = __builtin_amdgcn_mfma_f32_32x32x16_bf16(kf[2 * s], qf[s], s0, 0, 0, 0); s1 = __builtin_amdgcn_mfma_f32_32x32x16_bf16(kf[2 * s + 1], qf[s], s1, 0, 0, 0);
            }
            if (t >= cq - 2) {
                const LAS float* tb = tab + (MODE == 0 ? g * 256 : 0) + (64 * t - (qrow0 + r32) + 191 + 4 * hi);
#pragma unroll
                for (int r = 0; r < 16; ++r) { s0[r] += tb[(r & 3) + 8 * (r >> 2)]; s1[r] += tb[32 + (r & 3) + 8 * (r >> 2)]; }
            }
#pragma unroll
            for (int r = 0; r < 16; ++r) { s0[r] -= mrun; s1[r] -= mrun; }
            float rm = max3f(s0[0], s0[1], s1[0]), rm2 = max3f(s0[2], s0[3], s1[1]); rm = max3f(rm, s1[2], s1[3]);
#pragma unroll
            for (int r = 4; r < 16; r += 4) { rm = max3f(rm, s0[r], s0[r + 1]); rm2 = max3f(rm2, s0[r + 2], s0[r + 3]); rm = max3f(rm, s1[r], s1[r + 1]); rm2 = max3f(rm2, s1[r + 2], s1[r + 3]); }
            rm = max3f(rm, rm2, rm2);
            { auto rr = __builtin_amdgcn_permlane32_swap(__float_as_uint(rm), __float_as_uint(rm), false, false); rm = max3f(__uint_as_float(rr[0]), __uint_as_float(rr[1]), rm); }
            const bool first = (t == tfirst);
            if (__any(rm > 8.0f) || first) {
                const float dl = first ? rm : fmaxf(rm, 0.f), al = first ? 0.f : fast_exp2(-dl);
                lrun *= al; mrun += dl;
#pragma unroll
                for (int r = 0; r < 16; ++r) { s0[r] -= dl; s1[r] -= dl; }
                if (hi == 0) wsf[r32] = al;
                __builtin_amdgcn_wave_barrier();
#pragma unroll
                for (int r = 0; r < 16; ++r) { const float f = wsf[crow(r, hi)];
#pragma unroll
                    for (int d = 0; d < NDB; ++d) o[d][r] *= f; }
                __builtin_amdgcn_wave_barrier();
            }
            float ls = 0.f;
#pragma unroll
            for (int r = 0; r < 16; ++r) { s0[r] = fast_exp2(s0[r]); s1[r] = fast_exp2(s1[r]); ls += s0[r] + s1[r]; }
            lrun += ls;
            bf16x8 pa[4];
            { u32x4 t0, t1, t2, t3;
              t0.x = cvt_pk_bf16(s0[0], s0[1]); t0.y = cvt_pk_bf16(s0[2], s0[3]); t0.z = cvt_pk_bf16(s0[4], s0[5]); t0.w = cvt_pk_bf16(s0[6], s0[7]);
              t1.x = cvt_pk_bf16(s0[8], s0[9]); t1.y = cvt_pk_bf16(s0[10], s0[11]); t1.z = cvt_pk_bf16(s0[12], s0[13]); t1.w = cvt_pk_bf16(s0[14], s0[15]);
              t2.x = cvt_pk_bf16(s1[0], s1[1]); t2.y = cvt_pk_bf16(s1[2], s1[3]); t2.z = cvt_pk_bf16(s1[4], s1[5]); t2.w = cvt_pk_bf16(s1[6], s1[7]);
              t3.x = cvt_pk_bf16(s1[8], s1[9]); t3.y = cvt_pk_bf16(s1[10], s1[11]); t3.z = cvt_pk_bf16(s1[12], s1[13]); t3.w = cvt_pk_bf16(s1[14], s1[15]);
              pa[0] = __builtin_bit_cast(bf16x8, t0); pa[1] = __builtin_bit_cast(bf16x8, t1); pa[2] = __builtin_bit_cast(bf16x8, t2); pa[3] = __builtin_bit_cast(bf16x8, t3); }
            ATT_SBAR();
            s16x4 vc[NDB == 4 ? 16 : 1];
            if (NDB == 4) {
#pragma unroll
                for (int i = 0; i < 8; ++i) { vc[2 * i] = vtr(tb_ + voff[NDB - 2 + (i >> 2)] + (i & 3) * 4096); vc[2 * i + 1] = vtr(tb_ + voff[NDB - 2 + (i >> 2)] + (i & 3) * 4096 + 2048); }
                ATT_SBAR();
            }
#define ATT_VF(arr, i) (bf16x8){arr[2 * (i)][0], arr[2 * (i)][1], arr[2 * (i)][2], arr[2 * (i)][3], arr[2 * (i) + 1][0], arr[2 * (i) + 1][1], arr[2 * (i) + 1][2], arr[2 * (i) + 1][3]}
#pragma unroll
            for (int ks = 0; ks < 4; ++ks) {
                o[0] = __builtin_amdgcn_mfma_f32_32x32x16_bf16(pa[ks], ATT_VF(va, ks), o[0], 0, 0, 0);
                o[1] = __builtin_amdgcn_mfma_f32_32x32x16_bf16(pa[ks], ATT_VF(va, 4 + ks), o[1], 0, 0, 0);
            }
            if (NDB == 4) {
#pragma unroll
                for (int ks = 0; ks < 4; ++ks) {
                    o[NDB - 2] = __builtin_amdgcn_mfma_f32_32x32x16_bf16(pa[ks], ATT_VF(vc, ks), o[NDB - 2], 0, 0, 0);
                    o[NDB - 1] = __builtin_amdgcn_mfma_f32_32x32x16_bf16(pa[ks], ATT_VF(vc, 4 + ks), o[NDB - 1], 0, 0, 0);
                }
            }
#undef ATT_VF
        }
        boff = (boff == 2 * STG) ? 0 : boff + STG; bnext = (bnext == 2 * STG) ? 0 : bnext + STG;
    }
    asm volatile("s_waitcnt lgkmcnt(0)" ::: "memory"); __builtin_amdgcn_s_barrier(); asm volatile("" ::: "memory");
#undef ATT_STAGE
#undef ATT_GLDS
    if (PRB & 4) { if (lane == 0 && o[0][0] == 123.f) P.Y[0] = 0; return; }
    const float lt = lrun + __shfl_xor(lrun, 32);
    if (hi == 0) wsf[32 + r32] = fast_rcp(lt);
    __builtin_amdgcn_wave_barrier();
    float inv[16];
#pragma unroll
    for (int r = 0; r < 16; ++r) inv[r] = wsf[32 + crow(r, hi)];
    if (MODE == 0) {
        bf16_t* yo = P.Y + grow0 * 1024 + qcol + 64 * g + r32;
#pragma unroll
        for (int r = 0; r < 16; ++r)
#pragma unroll
            for (int d = 0; d < NDB; ++d) yo[(size_t)crow(r, hi) * 1024 + 32 * d] = (bf16_t)(cvt_pk_bf16(o[d][r] * inv[r], 0.f) & 0xffffu);
        __syncthreads();
    } else {
        const float s1 = wave_sum(P.lq1[lane] * P.lk1[lane]), s2 = wave_sum(P.lq2[lane] * P.lk2[lane]);
        const float lam = __expf(s1) - __expf(s2) + 0.2f;
        LAS float* X = (LAS float*)lds;
        if (g == 1) {
#pragma unroll
            for (int r = 0; r < 16; ++r)
#pragma unroll
                for (int d = 0; d < 4; ++d) X[((wq * 16 + r) * 4 + d) * 64 + lane] = o[d][r] * inv[r] * lam;
        }
        __syncthreads();
        if (g == 0) {
            float sg[4];
#pragma unroll
            for (int d = 0; d < 4; ++d) sg[d] = P.subg[32 * d + r32] * 0.8f;
            bf16_t* yo = P.Y + grow0 * 1024 + qcol + r32;
#pragma unroll
            for (int r = 0; r < 16; ++r) {
                float dv[4]; float ss = 0.f;
#pragma unroll
                for (int d = 0; d < 4; ++d) { dv[d] = o[d][r] * inv[r] - X[((wq * 16 + r) * 4 + d) * 64 + lane]; ss += dv[d] * dv[d]; }
                ss += __shfl_xor(ss, 1); ss += __shfl_xor(ss, 2); ss += __shfl_xor(ss, 4); ss += __shfl_xor(ss, 8); ss += __shfl_xor(ss, 16);
                const float rn = __builtin_amdgcn_rsqf(ss * (1.0f / 128.0f) + EPS);
#pragma unroll
                for (int d = 0; d < 4; ++d) yo[(size_t)crow(r, hi) * 1024 + 32 * d] = (bf16_t)(cvt_pk_bf16(dv[d] * rn * sg[d], 0.f) & 0xffffu);
            }
        }
        __syncthreads();
    }
}
}

typedef GAS unsigned gu32;
#define XB_TMO      128
#define XB_XCNT(j)  (256  + 64 * (j))
#define XB_XSUB(j)  (1280 + 64 * (j))
#define XB_XGEN(j)  (2304 + 64 * (j))
#define XB_TOP      3328
#define XB_TOPGEN   3392
#define XCD_BAR_WORDS 3456
#define XB_SPIN_CAP (1u << 18)
__device__ __forceinline__ unsigned xb_ld(unsigned* p)              { return __hip_atomic_load(p, __ATOMIC_RELAXED, __HIP_MEMORY_SCOPE_AGENT); }
__device__ __forceinline__ unsigned xb_add(unsigned* p, unsigned v) { return __hip_atomic_fetch_add(p, v, __ATOMIC_RELAXED, __HIP_MEMORY_SCOPE_AGENT); }
__device__ __forceinline__ unsigned xb_xcc_id() { return (unsigned)__builtin_amdgcn_s_getreg((3 << 11) | 20) & 0xFu; }
#define XB_SPIN(cond, bar) do { unsigned _sp = 0; while (cond) { __builtin_amdgcn_s_sleep(1); \
    if ((++_sp & 255u) == 0u) { if (xb_ld(&(bar)[XB_TMO])) break; if (_sp > XB_SPIN_CAP) { atomicAdd(&(bar)[XB_TMO], 1u); break; } } } } while (0)
struct XcdBarrier { unsigned* bar; unsigned x; volatile LAS unsigned* st; };
__device__ __forceinline__ XcdBarrier xcd_barrier_post(unsigned* bar, volatile LAS unsigned* st) {
    XcdBarrier b; b.bar = bar; b.x = xb_xcc_id(); b.st = st;
    if (threadIdx.x == 0) (void)xb_add(&bar[XB_XCNT(b.x)], 1u);
    return b;
}
__device__ __forceinline__ void xcd_barrier_complete(unsigned* bar, unsigned x, unsigned& nloc, unsigned& nx) {
    const unsigned G = gridDim.x * gridDim.y * gridDim.z;
    unsigned sum, cnt, mine, sp = 0u;
    for (;;) {
        sum = 0u; cnt = 0u; mine = 0u;
#pragma unroll
        for (unsigned j = 0; j < 16; ++j) { const unsigned c = xb_ld(&bar[XB_XCNT(j)]); sum += c; cnt += (c > 0u) ? 1u : 0u; mine = (j == x) ? c : mine; }
        if (sum == G) break;
        __builtin_amdgcn_s_sleep(1);
        if ((++sp & 255u) == 0u) { if (xb_ld(&bar[XB_TMO])) break; if (sp > XB_SPIN_CAP) { atomicAdd(&bar[XB_TMO], 1u); break; } }
    }
    nloc = mine > 0u ? mine : 1u; nx = cnt > 0u ? cnt : 1u;
}
__device__ __forceinline__ void xcd_barrier(const XcdBarrier& b) {
    asm volatile("s_waitcnt vmcnt(0)" ::: "memory");
    __syncthreads();
    if (threadIdx.x == 0) {
        unsigned* bar = b.bar;
        __builtin_amdgcn_s_waitcnt(0);
        unsigned nloc = b.st[0], nx = b.st[1];
        if (nloc == 0u) { xcd_barrier_complete(bar, b.x, nloc, nx); b.st[0] = nloc; b.st[1] = nx; }
        const unsigned old = xb_add(&bar[XB_XSUB(b.x)], 1u);
        const unsigned gen = old / nloc;
        if (old + 1u == (gen + 1u) * nloc) {
            __builtin_amdgcn_fence(__ATOMIC_RELEASE, "agent");
            asm volatile("s_waitcnt vmcnt(0)" ::: "memory");
            const unsigned og = xb_add(&bar[XB_TOP], 1u);
            const unsigned tg = og / nx;
            if (og + 1u == (tg + 1u) * nx) xb_add(&bar[XB_TOPGEN], 1u);
            else XB_SPIN(xb_ld(&bar[XB_TOPGEN]) == tg, bar);
            __builtin_amdgcn_fence(__ATOMIC_ACQUIRE, "agent");
            xb_add(&bar[XB_XGEN(b.x)], 1u);
            asm volatile("s_waitcnt vmcnt(0)" ::: "memory");
        } else {
            XB_SPIN(xb_ld(&bar[XB_XGEN(b.x)]) == gen, bar);
            __builtin_amdgcn_fence(__ATOMIC_ACQUIRE, "agent");
            asm volatile("s_waitcnt vmcnt(0)" ::: "memory");
        }
    }
    __syncthreads();
}

__device__ __forceinline__ unsigned f2bf(float f) { unsigned u = __builtin_bit_cast(unsigned, f); return (u + 0x7fffu + ((u >> 16) & 1u)) >> 16; }
__device__ __forceinline__ unsigned pk2(float lo, float hi) { return f2bf(lo) | (f2bf(hi) << 16); }
template <bool SWI, bool GAIN>
__device__ __forceinline__ void p0_transpose_item(const float* W, int K, int N, const float* gain, bf16_t* WT, LAS float* scr, int item, int lane) {
    const int nblk = N / 32, kb = item / nblk, nb = item % nblk, k0 = 64 * kb, n0 = 32 * nb;
#pragma unroll 8
    for (int i = 0; i < 32; ++i) { const int kk = 2 * i + (lane >> 5); const float gk = GAIN ? gain[k0 + kk] : 1.0f; scr[kk * 33 + (lane & 31)] = W[(size_t)(k0 + kk) * N + n0 + (lane & 31)] * gk; }
    asm volatile("s_waitcnt lgkmcnt(0)" ::: "memory");
    int r0 = n0;
    if (SWI) { const int half = n0 >= DFF, nn = n0 - half * DFF; r0 = (nn >> 7) * 256 + half * 128 + (nn & 127); }
    const int c = lane & 7;
#pragma unroll
    for (int j = 0; j < 4; ++j) { const int n = (lane >> 3) + 8 * j; const LAS float* s = scr + (8 * c) * 33 + n;
        u32x4 o; o.x = pk2(s[0 * 33], s[1 * 33]); o.y = pk2(s[2 * 33], s[3 * 33]); o.z = pk2(s[4 * 33], s[5 * 33]); o.w = pk2(s[6 * 33], s[7 * 33]);
        *(GAS u32x4*)(WT + (size_t)(r0 + n) * K + k0 + 8 * c) = o; }
    asm volatile("s_waitcnt lgkmcnt(0)" ::: "memory");
}

constexpr int N_PHASES = 10;
struct Args { const float* in[21]; float* out; unsigned char* ws; int ph_lo, ph_hi; };
static_assert(sizeof(Args) == 21 * 8 + 8 + 8 + 8, "Args has no padding");

__global__ void __launch_bounds__(NWAVES * 64, 2) fwd_kernel(Args args) {
    extern __shared__ __attribute__((aligned(16))) unsigned char lds_raw[];
    LAS unsigned char* lds = (LAS unsigned char*)lds_raw;
    volatile LAS unsigned* MISC = (volatile LAS unsigned*)(lds + MISC_OFF);
    const int tid = threadIdx.x, lane = tid & 63, wave = __builtin_amdgcn_readfirstlane(tid >> 6);
    const int G = gridDim.x, bx = blockIdx.x;
    const int vcu = (G % 8 == 0) ? (bx % 8) * (G / 8) + bx / 8 : bx;
    unsigned char* ws = args.ws;
    const float* x = args.in[0]; const float* g_ffn1 = args.in[1]; const float* w_in1 = args.in[2]; const float* w_out1 = args.in[3];
    const float* g_mix = args.in[4]; const float* w_mix = args.in[5]; const float* b_gate = args.in[6]; const float* rel_a = args.in[7];
    const float* lq1 = args.in[8]; const float* lk1 = args.in[9]; const float* lq2 = args.in[10]; const float* lk2 = args.in[11];
    const float* subg = args.in[12]; const float* t5 = args.in[13]; const float* w_a = args.in[14]; const float* w_b = args.in[15];
    const float* w_o = args.in[16]; const float* g_ffn2 = args.in[17]; const float* w_in2 = args.in[18]; const float* w_out2 = args.in[19]; const float* g_fin = args.in[20];
    float* out = args.out;
    float* SSQ0 = (float*)(ws + WS_SSQ0); float* SSQ1 = (float*)(ws + WS_SSQ1); float* SSQ2 = (float*)(ws + WS_SSQ2); float* SSQ3 = (float*)(ws + WS_SSQ3);
    bf16_t* WIN1 = (bf16_t*)(ws + WS_WIN1); bf16_t* WOUT1 = (bf16_t*)(ws + WS_WOUT1); bf16_t* WMIX = (bf16_t*)(ws + WS_WMIX); bf16_t* WA = (bf16_t*)(ws + WS_WA);
    bf16_t* WB = (bf16_t*)(ws + WS_WB); bf16_t* WO = (bf16_t*)(ws + WS_WO); bf16_t* WIN2 = (bf16_t*)(ws + WS_WIN2); bf16_t* WOUT2 = (bf16_t*)(ws + WS_WOUT2);
    bf16_t* XB = (bf16_t*)(ws + WS_XB); bf16_t* HB = (bf16_t*)(ws + WS_H);
    bf16_t* QQ = (bf16_t*)(ws + WS_QQ); bf16_t* KA = (bf16_t*)(ws + WS_KA); bf16_t* VA = (bf16_t*)(ws + WS_VA); bf16_t* KB = (bf16_t*)(ws + WS_KB); bf16_t* VB = (bf16_t*)(ws + WS_VB);
    bf16_t* GA = (bf16_t*)(ws + WS_GA); bf16_t* GB = (bf16_t*)(ws + WS_GB); bf16_t* MG = (bf16_t*)(ws + WS_MG);

    for (int u = tid; u < (LDS_BYTES - LDSCTL_OFF) / 4; u += NWAVES * 64) ((LAS unsigned*)(lds + LDSCTL_OFF))[u] = 0u;
    __syncthreads();
    const int lo = args.ph_lo, hi = args.ph_hi;
    const bool one_launch = (hi - lo) > 1;
    XcdBarrier bar; bar.bar = (unsigned*)(ws + WS_CTL) + CW_BAR; bar.x = 0; bar.st = nullptr;
    if (one_launch) bar = xcd_barrier_post((unsigned*)(ws + WS_CTL) + CW_BAR, MISC + 8);
#define IN(k) (lo <= (k) && (k) < hi)
#define SEAM(k) do { if (IN(k) && IN((k) + 1)) { xcd_barrier(bar); } } while (0)

    if (IN(0)) for (int rep_ = 0; rep_ < (PROBE_DUP == 0 ? 2 : 1); ++rep_) {
        LAS float* scr = (LAS float*)(lds + wave * 16384);
        const int gw = vcu * NWAVES + wave, NGW = G * NWAVES;
        constexpr int I_IN = (DM / 64) * (NFF / 32), I_OUT = (DFF / 64) * (DM / 32), I_MIX = (DM / 64) * (NMIX / 32), I_BR = (512 / 64) * (DM / 32), I_O = (DM / 64) * (DM / 32);
        constexpr int NITEMS = 2 * I_IN + 2 * I_OUT + I_MIX + 2 * I_BR + I_O;
        for (int it = gw; it < NITEMS; it += NGW) {
            int r = it;
            if (r < I_IN) { p0_transpose_item<true, true>(w_in1, DM, NFF, g_ffn1, WIN1, scr, r, lane); continue; } r -= I_IN;
            if (r < I_IN) { p0_transpose_item<true, true>(w_in2, DM, NFF, g_ffn2, WIN2, scr, r, lane); continue; } r -= I_IN;
            if (r < I_OUT) { p0_transpose_item<false, false>(w_out1, DFF, DM, nullptr, WOUT1, scr, r, lane); continue; } r -= I_OUT;
            if (r < I_OUT) { p0_transpose_item<false, false>(w_out2, DFF, DM, nullptr, WOUT2, scr, r, lane); continue; } r -= I_OUT;
            if (r < I_MIX) { p0_transpose_item<false, true>(w_mix, DM, NMIX, g_mix, WMIX, scr, r, lane); continue; } r -= I_MIX;
            if (r < I_BR) { p0_transpose_item<false, false>(w_a, 512, DM, nullptr, WA, scr, r, lane); continue; } r -= I_BR;
            if (r < I_BR) { p0_transpose_item<false, false>(w_b, 512, DM, nullptr, WB, scr, r, lane); continue; } r -= I_BR;
            p0_transpose_item<false, false>(w_o, DM, DM, nullptr, WO, scr, r, lane);
        }
        for (int m = gw; m < M; m += NGW) {
            const GAS f32x4* xr = (const GAS f32x4*)(x + (size_t)m * DM) + lane;
            f32x4 v[4]; float s = 0.f;
#pragma unroll
            for (int j = 0; j < 4; ++j) { v[j] = xr[64 * j]; s += (v[j].x * v[j].x + v[j].y * v[j].y) + (v[j].z * v[j].z + v[j].w * v[j].w); }
            s = wave_sum(s);
            GAS u32x2* o8 = (GAS u32x2*)(XB + (size_t)m * DM) + lane;
#pragma unroll
            for (int j = 0; j < 4; ++j) { u32x2 wv; wv.x = cvt_pk_bf16(v[j].x, v[j].y); wv.y = cvt_pk_bf16(v[j].z, v[j].w); o8[64 * j] = wv; }
            if (lane < 4) SSQ0[(size_t)m * 4 + lane] = lane == 0 ? s : 0.f;
        }
    }
    SEAM(0);
    if (IN(1)) {
        pg8::Gemm g{DM, DM, DM}; pg8::StaticOrder S{XB, WIN1, DM, DM, M / 256, NFF / 256, G, bx};
        pg8::EpiSwiglu E{HB, SSQ0};
        pg8::gemm_phase(lds, g, S, E);
        if (PROBE_DUP == 1) { __syncthreads(); pg8::gemm_phase(lds, g, S, E); }
        if (PROBE_DUP == 11) { __syncthreads(); pg8::EpiNull E0{HB, nullptr}; pg8::gemm_phase(lds, g, S, E0); }
    }
    SEAM(1);
    if (PROBE_DUP == 100 && one_launch) { for (int i_ = 0; i_ < 8; ++i_) xcd_barrier(bar); }
    if (PROBE_DUP == 101 && one_launch) { cg::this_grid().sync(); cg::this_grid().sync(); }
    if (IN(2)) {
        pg8::Gemm g{DFF, DFF, DFF}; pg8::StaticOrder S{HB, WOUT1, DFF, DFF, M / 256, DM / 256, G, bx};
        pg8::EpiResid<false> E{x, nullptr, XB, SSQ1, 0.5f};
        for (int i0 = 0;; ++i0) { pg8::OneUnit S1{S, i0}; pg8::Unit u_; if (!S1.next(0, u_)) break; pg8::gemm_phase(lds, g, S1, E); }
        if (PROBE_DUP == 2) { __syncthreads(); pg8::OneUnit S1{S, 0}; pg8::gemm_phase(lds, g, S1, E); }
    }
    SEAM(2);
    if (IN(3)) {
        pg8::Gemm g{DM, DM, DM}; pg8::StaticOrder S{XB, WMIX, DM, DM, M / 256, NMIX / 256, G, bx};
        pg8::EpiMix E{QQ, KA, VA, KB, VB, GA, GB, SSQ1, b_gate};
        pg8::gemm_phase(lds, g, S, E);
        if (PROBE_DUP == 3) { __syncthreads(); pg8::gemm_phase(lds, g, S, E); }
    }
    SEAM(3);
    if (IN(4)) {
        att::Params P{QQ, KA, VA, KB, VB, QQ, rel_a, t5, lq1, lk1, lq2, lk2, subg};
        if (PROBE_DUP >= 40 && PROBE_DUP < 80) {
            constexpr int PR = (PROBE_DUP >= 40 && PROBE_DUP < 80) ? (PROBE_DUP - 40) & 7 : 0; constexpr int WHICH = (PROBE_DUP >= 40 && PROBE_DUP < 80) ? (PROBE_DUP - 40) >> 3 : 0;
            att::Params P2{QQ, KA, VA, KB, VB, XB, rel_a, t5, lq1, lk1, lq2, lk2, subg};
            for (int v = vcu; v < 256; v += G) {
                const int bh = v >> 3, j = v & 7, b = bh >> 2, hp = bh & 3;
                if (WHICH != 2) { att::unit<1, PR>((LAS char*)lds, P2, b, hp, 15 - j); att::unit<1, PR>((LAS char*)lds, P2, b, hp, j); }
                if (WHICH != 1) { att::unit<0, PR>((LAS char*)lds, P2, b, hp, 15 - j); att::unit<0, PR>((LAS char*)lds, P2, b, hp, j); }
            }
            __syncthreads();
        }
        for (int v = vcu; v < 256; v += G) {
            const int bh = v >> 3, j = v & 7, b = bh >> 2, hp = bh & 3;
            att::unit<1>((LAS char*)lds, P, b, hp, 15 - j);
            att::unit<0>((LAS char*)lds, P, b, hp, 15 - j);
            att::unit<1>((LAS char*)lds, P, b, hp, j);
            att::unit<0>((LAS char*)lds, P, b, hp, j);
        }
    }
    SEAM(4);
    if (IN(5)) {
        pg8::Gemm g{DM, 512, 512}; pg8::BranchOrder S{QQ, QQ + 512, WA, WB, DM, 512, M / 256, DM / 256, G, bx};
        pg8::EpiBranch E{GA, GB, MG, nullptr};
        pg8::gemm_phase(lds, g, S, E);
        if (PROBE_DUP == 5) { __syncthreads(); pg8::gemm_phase(lds, g, S, E); }
    }
    SEAM(5);
    if (IN(6)) {
        pg8::Gemm g{DM, DM, DM}; pg8::StaticOrder S{MG, WO, DM, DM, M / 256, DM / 256, G, bx};
        pg8::EpiResid<true> E{XB, nullptr, XB, SSQ2, 1.0f};
        for (int i0 = 0;; ++i0) { pg8::OneUnit S1{S, i0}; pg8::Unit u_; if (!S1.next(0, u_)) break; pg8::gemm_phase(lds, g, S1, E); }
    }
    SEAM(6);
    if (IN(7)) {
        pg8::Gemm g{DM, DM, DM}; pg8::StaticOrder S{XB, WIN2, DM, DM, M / 256, NFF / 256, G, bx};
        pg8::EpiSwiglu E{HB, SSQ2};
        pg8::gemm_phase(lds, g, S, E);
    }
    SEAM(7);
    if (IN(8)) {
        pg8::Gemm g{DFF, DFF, DFF}; pg8::StaticOrder S{HB, WOUT2, DFF, DFF, M / 256, DM / 256, G, bx};
        pg8::EpiResid<true> E{XB, out, nullptr, SSQ3, 0.5f};
        for (int i0 = 0;; ++i0) { pg8::OneUnit S1{S, i0}; pg8::Unit u_; if (!S1.next(0, u_)) break; pg8::gemm_phase(lds, g, S1, E); }
    }
    SEAM(8);
    if (IN(9)) {
        const int gw = vcu * NWAVES + wave, NGW = G * NWAVES;
        f32x4 gv[4];
#pragma unroll
        for (int j = 0; j < 4; ++j) gv[j] = ((const f32x4*)g_fin)[lane + 64 * j];
        if (PROBE_DUP == 9) for (int m = gw; m < M; m += NGW) {
            const float rs = row_rstd(SSQ3, m);
            const f32x4* xr = (const f32x4*)(out + (size_t)m * DM) + lane; f32x4* xo = (f32x4*)(ws + WS_XB + (size_t)m * DM * 4) + lane;
#pragma unroll
            for (int j = 0; j < 4; ++j) { const f32x4 v = xr[64 * j]; xo[64 * j] = v * rs * gv[j]; }
        }
        for (int m = gw; m < M; m += NGW) {
            const float rs = row_rstd(SSQ3, m);
            f32x4* xr = (f32x4*)(out + (size_t)m * DM) + lane;
#pragma unroll
            for (int j = 0; j < 4; ++j) { const f32x4 v = xr[64 * j]; xr[64 * j] = v * rs * gv[j]; }
        }
    }
#undef IN
#undef SEAM
}

extern "C" void kernel_launch(void* const* d_in, const int* in_sizes, int n_in, void* d_out, int out_size, void* d_ws, size_t ws_size, hipStream_t stream) {
    static int grid = 0;
    if (grid == 0) {
        if (n_in != 21 || in_sizes[0] != M * DM || out_size != M * DM || ws_size < WS_END) { fprintf(stderr, "kernel_launch: unexpected shapes (n_in %d, in0 %d, out %d, ws %zu); nothing launched\n", n_in, n_in > 0 ? in_sizes[0] : -1, out_size, ws_size); grid = -1; return; }
        int dev = 0, cus = 0, per_cu = 0;
        if (hipGetDevice(&dev) != hipSuccess || hipDeviceGetAttribute(&cus, hipDeviceAttributeMultiprocessorCount, dev) != hipSuccess) { fprintf(stderr, "kernel_launch: device query failed\n"); grid = -1; return; }
        if (hipFuncSetAttribute((const void*)fwd_kernel, hipFuncAttributeMaxDynamicSharedMemorySize, LDS_BYTES) != hipSuccess) { fprintf(stderr, "kernel_launch: hipFuncSetAttribute failed\n"); grid = -1; return; }
        if (hipOccupancyMaxActiveBlocksPerMultiprocessor(&per_cu, (const void*)fwd_kernel, NWAVES * 64, LDS_BYTES) != hipSuccess || per_cu < 1) { fprintf(stderr, "kernel_launch: occupancy query says %d blocks per CU\n", per_cu); per_cu = 1; }
        (void)hipGetLastError();
        grid = cus;
    }
    if (grid < 0) return;
    if (hipMemsetAsync((char*)d_ws + WS_CTL, 0, CTL_ZERO_BYTES, stream) != hipSuccess) { fprintf(stderr, "kernel_launch: hipMemsetAsync failed\n"); return; }
    Args a{};
    for (int i = 0; i < 21; ++i) a.in[i] = (const float*)d_in[i];
    a.out = (float*)d_out; a.ws = (unsigned char*)d_ws;
#if MK_N_LAUNCHES == 1
    a.ph_lo = 0; a.ph_hi = N_PHASES;
    void* kargs[] = {&a};
#if MK_PLAIN_LAUNCH
    (void)kargs; hipLaunchKernelGGL(fwd_kernel, dim3(grid), dim3(NWAVES * 64), LDS_BYTES, stream, a);
#else
    hipError_t e = hipLaunchCooperativeKernel((const void*)fwd_kernel, dim3(grid), dim3(NWAVES * 64), kargs, LDS_BYTES, stream);
    if (e != hipSuccess) fprintf(stderr, "kernel_launch: cooperative launch failed: %s (grid %d)\n", hipGetErrorString(e), grid);
#endif
#else
    for (int p = 0; p < N_PHASES; ++p) {
        a.ph_lo = p; a.ph_hi = p + 1;
        hipLaunchKernelGGL(fwd_kernel, dim3(grid), dim3(NWAVES * 64), LDS_BYTES, stream, a);
    }
#endif
}
```
